# Optimizing an MI355X kernel written in HIP

```python
import math
import jax, jax.numpy as jnp
from jax import lax
import numpy as np

D_MODEL = 1024
BATCH = 8
SEQ = 4096
DEPTH = 2

GRID_W = 64
CTX_LEN = 256
MIX_WIDTH = 2 * D_MODEL
SSD_WIDTH = D_MODEL
SSD_HEAD_DIM = 64
SSD_HEADS = SSD_WIDTH // SSD_HEAD_DIM
SSD_GROUPS = 2
SSD_HPG = SSD_HEADS // SSD_GROUPS
SSD_STATE = 128
SSD_CHUNK = 128
CONV_K = 3
CONV_CH = SSD_WIDTH + 2 * SSD_GROUPS * SSD_STATE
GLA_HEADS = 4
GLA_V_WIDTH = MIX_WIDTH - SSD_WIDTH
GLA_K_WIDTH = GLA_V_WIDTH // 2
GLA_DK = GLA_K_WIDTH // GLA_HEADS
GLA_DV = GLA_V_WIDTH // GLA_HEADS
GLA_GATE_RANK = 16
GLA_GATE_NORM = 16.0
GLA_CHUNK = 64
D_FF = 4 * D_MODEL
EPS = 1e-6
IN_COLS = (2 * SSD_WIDTH + 2 * SSD_GROUPS * SSD_STATE + 2 * SSD_HEADS
           + 2 * GLA_K_WIDTH + 2 * GLA_V_WIDTH + 2 * GLA_GATE_RANK)

kernel_name = 'hybrid_ssd_gla_prefix_dit_block'


def _in_split_points():
    widths = [SSD_WIDTH, SSD_WIDTH, SSD_GROUPS * SSD_STATE, SSD_GROUPS * SSD_STATE,
              SSD_HEADS, SSD_HEADS, GLA_K_WIDTH, GLA_K_WIDTH, GLA_V_WIDTH, GLA_V_WIDTH,
              GLA_GATE_RANK, GLA_GATE_RANK]
    pts, acc = [], 0
    for w in widths[:-1]:
        acc += w
        pts.append(acc)
    return pts


def rms_norm(x, g):
    xf = x.astype(jnp.float32)
    y = xf * lax.rsqrt(jnp.mean(xf * xf, axis=-1, keepdims=True) + EPS)
    return (y * g.astype(jnp.float32)).astype(x.dtype)


def modulate(h, shift, scale):
    return h * (1 + scale) + shift


def dw_conv_grid(u, w, bias, rows, cols):
    b, L, ch = u.shape
    img = u.reshape(b, rows, cols, ch)
    out = lax.conv_general_dilated(img, w[:, :, None, :].astype(u.dtype), window_strides=(1, 1),
                                   padding='SAME', dimension_numbers=('NHWC', 'HWIO', 'NHWC'),
                                   feature_group_count=ch)
    return (out + bias.astype(u.dtype)).reshape(b, L, ch)


def ssd_chunked_scan(xh, dt, A, Bm, Cm, h0):
    f32 = jnp.float32
    b, L, G, HG, P = xh.shape
    N = Bm.shape[-1]
    Q = SSD_CHUNK
    nc = L // Q
    x = xh.astype(f32).reshape(b, nc, Q, G, HG, P)
    dt = dt.reshape(b, nc, Q, G, HG)
    Bc = Bm.astype(f32).reshape(b, nc, Q, G, N)
    Cc = Cm.astype(f32).reshape(b, nc, Q, G, N)
    a_cum = jnp.cumsum(dt * A, axis=2)
    xdt = x * dt[..., None]
    a_t = jnp.moveaxis(a_cum, 2, -1)
    diff = a_t[..., :, None] - a_t[..., None, :]
    lower = jnp.tril(jnp.ones((Q, Q), dtype=bool))
    decay = jnp.exp(jnp.where(lower, diff, -jnp.inf))
    cb = jnp.einsum('bcign,bcjgn->bcgij', Cc, Bc)
    y_diag = jnp.einsum('bcghij,bcjghp->bcighp', cb[:, :, :, None] * decay, xdt)
    decay_to_end = jnp.exp(a_cum[:, :, -1:] - a_cum)
    states = jnp.einsum('bcjgn,bcjghp->bcghpn', Bc, xdt * decay_to_end[..., None])
    chunk_decay = jnp.exp(a_cum[:, :, -1])

    def step(h, inp):
        dec, st = inp
        return dec[..., None, None] * h + st, h

    h_final, h_prev = lax.scan(step, h0, (jnp.moveaxis(chunk_decay, 1, 0), jnp.moveaxis(states, 1, 0)))
    h_prev = jnp.moveaxis(h_prev, 0, 1)
    y_off = jnp.einsum('bcign,bcghpn->bcighp', Cc, h_prev) * jnp.exp(a_cum)[..., None]
    return (y_diag + y_off).reshape(b, L, G, HG, P), h_final


def gla_chunked_scan(q, k, v, log_a, S0):
    b, L, H, DK = q.shape
    DV = v.shape[-1]
    C = GLA_CHUNK
    nc = L // C
    q = q.reshape(b, nc, C, H, DK)
    k = k.reshape(b, nc, C, H, DK)
    v = v.reshape(b, nc, C, H, DV)
    bcum = jnp.cumsum(log_a.reshape(b, nc, C, H, DK), axis=2)
    b_last = bcum[:, :, -1:]
    q_dec = q * jnp.exp(bcum)
    k_inv = k * jnp.exp(-bcum)
    k_end = k * jnp.exp(b_last - bcum)
    lower = jnp.tril(jnp.ones((C, C), dtype=bool))
    att = jnp.where(lower, jnp.einsum('bcihd,bcjhd->bchij', q_dec, k_inv), 0.0)
    o_intra = jnp.einsum('bchij,bcjhv->bcihv', att, v)
    U = jnp.einsum('bcjhd,bcjhv->bchdv', k_end, v)
    dec = jnp.exp(b_last[:, :, 0])

    def step(S, inp):
        a, u_ = inp
        return a[..., None] * S + u_, S

    S_T, S_prev = lax.scan(step, S0, (jnp.moveaxis(dec, 1, 0), jnp.moveaxis(U, 1, 0)))
    S_prev = jnp.moveaxis(S_prev, 0, 1)
    o_inter = jnp.einsum('bcihd,bchdv->bcihv', q_dec, S_prev)
    return (o_intra + o_inter).reshape(b, L, H, DV), S_T


def hybrid_mixer(u, rows, cols, init, w_in, conv_w, conv_b, dt_bias, a_log, d_skip,
                 ssd_norm_g, gla_w2, gla_b2, gla_norm_g):
    f32 = jnp.float32
    b, L, _ = u.shape
    flip = lambda t: jnp.flip(t, axis=1)
    proj = u @ w_in
    z, xs, Bm, Cm, dt_f, dt_b, q, k, v, r, ga_f, ga_b = jnp.split(proj, _in_split_points(), axis=-1)

    xbc = jax.nn.silu(dw_conv_grid(jnp.concatenate([xs, Bm, Cm], axis=-1), conv_w, conv_b, rows, cols))
    xs, Bm, Cm = jnp.split(xbc, [SSD_WIDTH, SSD_WIDTH + SSD_GROUPS * SSD_STATE], axis=-1)
    xh = xs.reshape(b, L, SSD_GROUPS, SSD_HPG, SSD_HEAD_DIM)
    Bm = Bm.reshape(b, L, SSD_GROUPS, SSD_STATE)
    Cm = Cm.reshape(b, L, SSD_GROUPS, SSD_STATE)

    def ssd_direction(d, dt_raw, xh_, B_, C_, h0):
        dt = jax.nn.softplus(dt_raw.astype(f32) + dt_bias[d].astype(f32)).reshape(b, L, SSD_GROUPS, SSD_HPG)
        A = -jnp.exp(a_log[d].astype(f32)).reshape(SSD_GROUPS, SSD_HPG)
        y, hT = ssd_chunked_scan(xh_, dt, A, B_, C_, h0)
        return y + d_skip[d].astype(f32).reshape(SSD_GROUPS, SSD_HPG, 1) * xh_.astype(f32), hT

    y_f, hs_f = ssd_direction(0, dt_f, xh, Bm, Cm, init[0])
    y_b, hs_b = ssd_direction(1, flip(dt_b), flip(xh), flip(Bm), flip(Cm), init[1])
    y = (y_f + flip(y_b)).reshape(b, L, SSD_WIDTH) * jax.nn.silu(z.astype(f32))
    y = rms_norm(y.reshape(b, L, SSD_GROUPS, SSD_WIDTH // SSD_GROUPS),
                 ssd_norm_g.reshape(SSD_GROUPS, SSD_WIDTH // SSD_GROUPS)).reshape(b, L, SSD_WIDTH)

    qh = q.astype(f32).reshape(b, L, GLA_HEADS, GLA_DK) * (GLA_DK ** -0.5)
    kh = k.astype(f32).reshape(b, L, GLA_HEADS, GLA_DK)
    vh = v.astype(f32).reshape(b, L, GLA_HEADS, GLA_DV)

    def gla_direction(d, ga, q_, k_, v_, S0):
        log_a = jax.nn.log_sigmoid((ga @ gla_w2[d] + gla_b2[d]).astype(f32)) / GLA_GATE_NORM
        return gla_chunked_scan(q_, k_, v_, log_a.reshape(b, L, GLA_HEADS, GLA_DK), S0)

    o_f, S_f = gla_direction(0, ga_f, qh, kh, vh, init[2])
    o_b, S_b = gla_direction(1, flip(ga_b), flip(qh), flip(kh), flip(vh), init[3])
    o = rms_norm(o_f + flip(o_b), gla_norm_g).reshape(b, L, GLA_V_WIDTH) * jax.nn.silu(r.astype(f32))

    heads = jnp.concatenate([y, o], axis=-1).astype(u.dtype)
    return heads, (hs_f, hs_b, S_f, S_b)


def sq_relu_mlp(h, w1, w2):
    return jnp.square(jax.nn.relu(h @ w1)) @ w2


def setup_inputs(seed: int = 0) -> dict:
    key = jax.random.key(seed)
    ks = jax.random.split(key, 24)
    D = D_MODEL
    f32 = jnp.float32

    def nrm(k, shape, scale):
        return jax.random.normal(k, shape, f32) * scale

    dt0 = jnp.exp(jax.random.uniform(ks[10], (DEPTH, 2, SSD_HEADS), f32)
                  * (math.log(0.1) - math.log(0.001)) + math.log(0.001))
    return {
        'x': nrm(ks[0], (BATCH, SEQ, D), 1.0),
        'c': nrm(ks[1], (BATCH, D), 1.0),
        'ctx': nrm(ks[2], (BATCH, CTX_LEN, D), 1.0),
        'c_ctx': nrm(ks[3], (D,), 1.0),
        'w_ada': nrm(ks[4], (DEPTH, D, 6 * D), 0.5 * D ** -0.5),
        'b_ada': nrm(ks[5], (DEPTH, 6 * D), 0.02),
        'norm1_g': 1.0 + nrm(ks[6], (DEPTH, D), 0.02),
        'w_in': nrm(ks[7], (DEPTH, D, IN_COLS), D ** -0.5),
        'conv_w': nrm(ks[8], (DEPTH, CONV_K, CONV_K, CONV_CH), 1.0 / CONV_K),
        'conv_b': nrm(ks[9], (DEPTH, CONV_CH), 0.02),
        'dt_bias': dt0 + jnp.log(-jnp.expm1(-dt0)),
        'a_log': jnp.log(jax.random.uniform(ks[11], (DEPTH, 2, SSD_HEADS), f32, minval=1.0, maxval=16.0)),
        'd_skip': 1.0 + nrm(ks[12], (DEPTH, 2, SSD_HEADS), 0.02),
        'ssd_norm_g': 1.0 + nrm(ks[13], (DEPTH, SSD_WIDTH), 0.02),
        'gla_w2': nrm(ks[14], (DEPTH, 2, GLA_GATE_RANK, GLA_K_WIDTH), GLA_GATE_RANK ** -0.5),
        'gla_b2': nrm(ks[15], (DEPTH, 2, GLA_K_WIDTH), 0.02),
        'gla_norm_g': 1.0 + nrm(ks[16], (DEPTH, GLA_DV), 0.02),
        'w_out': nrm(ks[17], (DEPTH, MIX_WIDTH, D), MIX_WIDTH ** -0.5),
        'norm2_g': 1.0 + nrm(ks[18], (DEPTH, D), 0.02),
        'w_ff1': nrm(ks[19], (DEPTH, D, D_FF), D ** -0.5),
        'w_ff2': nrm(ks[20], (DEPTH, D_FF, D), D_FF ** -0.5),
        'final_norm_g': 1.0 + nrm(ks[21], (D,), 0.02),
    }


def reference(x, c, ctx, c_ctx, w_ada, b_ada, norm1_g, w_in, conv_w, conv_b, dt_bias, a_log,
              d_skip, ssd_norm_g, gla_w2, gla_b2, gla_norm_g, w_out, norm2_g, w_ff1, w_ff2,
              final_norm_g):
    f32 = jnp.float32
    bsz, n_lat, _ = x.shape
    rows = n_lat // GRID_W
    ctx_len = ctx.shape[1]
    zero_states = (jnp.zeros((bsz, SSD_GROUPS, SSD_HPG, SSD_HEAD_DIM, SSD_STATE), f32),
                   jnp.zeros((bsz, SSD_GROUPS, SSD_HPG, SSD_HEAD_DIM, SSD_STATE), f32),
                   jnp.zeros((bsz, GLA_HEADS, GLA_DK, GLA_DV), f32),
                   jnp.zeros((bsz, GLA_HEADS, GLA_DK, GLA_DV), f32))
    h_lat, h_ctx = x, ctx
    for l in range(DEPTH):
        mix_params = (w_in[l], conv_w[l], conv_b[l], dt_bias[l], a_log[l], d_skip[l],
                      ssd_norm_g[l], gla_w2[l], gla_b2[l], gla_norm_g[l])
        m_lat = jnp.split(jax.nn.silu(c) @ w_ada[l] + b_ada[l], 6, axis=-1)
        sh1, sc1, g1, sh2, sc2, g2 = [m[:, None, :] for m in m_lat]
        csh1, csc1, cg1, csh2, csc2, cg2 = jnp.split(jax.nn.silu(c_ctx) @ w_ada[l] + b_ada[l], 6, axis=-1)

        u_ctx = modulate(rms_norm(h_ctx, norm1_g[l]), csh1, csc1)
        heads_ctx, ctx_states = hybrid_mixer(u_ctx, 1, ctx_len, zero_states, *mix_params)

        u_lat = modulate(rms_norm(h_lat, norm1_g[l]), sh1, sc1)
        heads_lat, _ = hybrid_mixer(u_lat, rows, GRID_W, ctx_states, *mix_params)
        h_lat = h_lat + g1 * (heads_lat @ w_out[l])
        h_lat = h_lat + g2 * sq_relu_mlp(modulate(rms_norm(h_lat, norm2_g[l]), sh2, sc2), w_ff1[l], w_ff2[l])

        if l < DEPTH - 1:
            h_ctx = h_ctx + cg1 * (heads_ctx @ w_out[l])
            h_ctx = h_ctx + cg2 * sq_relu_mlp(modulate(rms_norm(h_ctx, norm2_g[l]), csh2, csc2), w_ff1[l], w_ff2[l])
    return rms_norm(h_lat, final_norm_g)
```

```cpp
#include <hip/hip_runtime.h>
#include <hip/hip_cooperative_groups.h>
#include <cstdio>
namespace cg = cooperative_groups;

typedef unsigned short u16;
typedef short bf16x8 __attribute__((ext_vector_type(8)));
typedef short s16x4 __attribute__((ext_vector_type(4)));
typedef float f32x16 __attribute__((ext_vector_type(16)));
typedef __bf16 bf16x2_t __attribute__((ext_vector_type(2)));
typedef float f32x2_t __attribute__((ext_vector_type(2)));
typedef unsigned u32x4 __attribute__((ext_vector_type(4)));
typedef unsigned u32x2 __attribute__((ext_vector_type(2)));

#define DI __device__ __forceinline__
#define NT 512
#define LDS_BYTES 131072
#define MFMA32(a, b, c) __builtin_amdgcn_mfma_f32_32x32x16_bf16((a), (b), (c), 0, 0, 0)

constexpr int TC = 2048;
constexpr int TL = 32768;
constexpr int TT = TC + TL;
constexpr int INC = 5696;
constexpr int INP = 5888;
constexpr float EPS = 1e-6f;

constexpr size_t SZ_A = (size_t)TT * 1536 * 2;
constexpr size_t SZ_1K = (size_t)TT * 1024 * 2;
constexpr size_t OFF_A = 0;
constexpr size_t OFF_B = OFF_A + SZ_A;
constexpr size_t OFF_C = OFF_B + SZ_A;
constexpr size_t OFF_D = OFF_C + SZ_1K;
constexpr size_t OFF_E = OFF_D + SZ_1K;
constexpr size_t OFF_F = OFF_E + SZ_1K;
constexpr size_t SZ_G = (size_t)TT * 32 * 4;
constexpr size_t OFF_DT = OFF_F + SZ_1K;
constexpr size_t OFF_GA = OFF_DT + SZ_G;
constexpr size_t OFF_HCTX = OFF_GA + SZ_G;
constexpr size_t OFF_MODS = OFF_HCTX + (size_t)TC * 1024 * 4;
constexpr size_t OFF_END = OFF_MODS + (size_t)2 * 9 * 6144 * 4;
constexpr size_t OFF_WIN = OFF_B + SZ_1K;
constexpr size_t OFF_BAR = OFF_END + (size_t)4 * 1024 * 1024;
constexpr size_t OFF_WOUT = OFF_END;
constexpr size_t OFF_WFF1 = OFF_BAR + (size_t)16 * 1024;
constexpr size_t OFF_WFF2 = OFF_A + (size_t)92 * 1024 * 1024;
constexpr size_t OFF_SLAB = OFF_A + (size_t)68 * 1024 * 1024;
constexpr int NSPLIT = 4;
constexpr int TEMP_ELEMS = 4352 * 32;

struct Params {
  const float* in[22];
  float* out;
  unsigned char* ws;
};

DI unsigned pack2(float a, float b) {
  f32x2_t v = {a, b};
  bf16x2_t r = __builtin_convertvector(v, bf16x2_t);
  return __builtin_bit_cast(unsigned, r);
}
DI u16 f2bf(float a) { return (u16)(pack2(a, 0.f) & 0xffffu); }
DI float bf2f(u16 v) { return __uint_as_float(((unsigned)v) << 16); }
DI float bflo(unsigned v) { return __uint_as_float(v << 16); }
DI float bfhi(unsigned v) { return __uint_as_float(v & 0xffff0000u); }
DI float wave_sum(float v) {
#pragma unroll
  for (int o = 32; o >= 1; o >>= 1) v += __shfl_xor(v, o);
  return v;
}
DI float siluf(float x) { return x * __builtin_amdgcn_rcpf(1.f + __builtin_amdgcn_exp2f(-1.4426950408889634f * x)); }
DI int get_tid() { int t = threadIdx.x; asm volatile("" : "+v"(t)); return t; }
DI int crow(int reg, int h) { return (reg & 3) + 8 * (reg >> 2) + 4 * h; }
DI bf16x8 ldfrag(const u16* p) { return *(const bf16x8*)p; }
DI s16x4 tr4(const u16* p) {
  return __builtin_amdgcn_ds_read_tr16_b64_v4i16((__attribute__((address_space(3))) s16x4*)p);
}
DI bf16x8 frag_tr(const u16* img, int ld, int k_lo, int k_hi, int c0, int lane) {
  const int i16 = lane & 15, q = i16 >> 2, pp = i16 & 3, blk = (lane >> 4) & 1;
  s16x4 lo = tr4(img + (k_lo + q) * ld + c0 + 16 * blk + 4 * pp);
  s16x4 hi = tr4(img + (k_hi + q) * ld + c0 + 16 * blk + 4 * pp);
  return __builtin_shufflevector(lo, hi, 0, 1, 2, 3, 4, 5, 6, 7);
}
DI bf16x8 pack_step(const f32x16& x, int s) {
  u32x4 p;
  p[0] = pack2(x[8 * s + 0], x[8 * s + 1]);
  p[1] = pack2(x[8 * s + 2], x[8 * s + 3]);
  p[2] = pack2(x[8 * s + 4], x[8 * s + 5]);
  p[3] = pack2(x[8 * s + 6], x[8 * s + 7]);
  return __builtin_bit_cast(bf16x8, p);
}
DI f32x16 zero16() {
  f32x16 z;
#pragma unroll
  for (int i = 0; i < 16; ++i) z[i] = 0.f;
  return z;
}

#define XB_TMO      128
#define XB_XCNT(j)  (256  + 64 * (j))
#define XB_XSUB(j)  (1280 + 64 * (j))
#define XB_XGEN(j)  (2304 + 64 * (j))
#define XB_TOP      3328
#define XB_TOPGEN   3392
#define XCD_BAR_WORDS 3456
#define XB_SPIN_CAP (1u << 18)
#define LAS __attribute__((address_space(3)))

__device__ __forceinline__ unsigned xb_ld(unsigned* p)              { return __hip_atomic_load(p, __ATOMIC_RELAXED, __HIP_MEMORY_SCOPE_AGENT); }
__device__ __forceinline__ unsigned xb_add(unsigned* p, unsigned v) { return __hip_atomic_fetch_add(p, v, __ATOMIC_RELAXED, __HIP_MEMORY_SCOPE_AGENT); }
__device__ __forceinline__ unsigned xb_xcc_id() { return (unsigned)__builtin_amdgcn_s_getreg((3 << 11) | 20) & 0xFu; }
#define XB_SPIN(cond, bar) do { unsigned _sp = 0; while (cond) { __builtin_amdgcn_s_sleep(1); \
    if ((++_sp & 255u) == 0u) { if (xb_ld(&(bar)[XB_TMO])) break; if (_sp > XB_SPIN_CAP) { atomicAdd(&(bar)[XB_TMO], 1u); break; } } } } while (0)

struct XcdBarrier {
    unsigned* bar; unsigned x;
    volatile LAS unsigned* st;
};

__device__ __forceinline__ XcdBarrier xcd_barrier_post(unsigned* bar, volatile LAS unsigned* st) {
    XcdBarrier b; b.bar = bar; b.x = xb_xcc_id(); b.st = st;
    if (threadIdx.x == 0) (void)xb_add(&bar[XB_XCNT(b.x)], 1u);
    return b;
}
__device__ __forceinline__ void xcd_barrier_complete(unsigned* bar, unsigned x, unsigned& nloc, unsigned& nx) {
    const unsigned G = gridDim.x * gridDim.y * gridDim.z;
    unsigned sum, cnt, mine, sp = 0u;
    for (;;) {
        sum = 0u; cnt = 0u; mine = 0u;
#pragma unroll
        for (unsigned j = 0; j < 16; ++j) { const unsigned c = xb_ld(&bar[XB_XCNT(j)]); sum += c; cnt += (c > 0u) ? 1u : 0u; mine = (j == x) ? c : mine; }
        if (sum == G) break;
        __builtin_amdgcn_s_sleep(1);
        if ((++sp & 255u) == 0u) { if (xb_ld(&bar[XB_TMO])) break; if (sp > XB_SPIN_CAP) { atomicAdd(&bar[XB_TMO], 1u); break; } }
    }
    nloc = mine > 0u ? mine : 1u; nx = cnt > 0u ? cnt : 1u;
}

__device__ __forceinline__ void xcd_barrier(const XcdBarrier& b) {
    asm volatile("s_waitcnt vmcnt(0)" ::: "memory");
    __syncthreads();
    if (threadIdx.x == 0) {
        unsigned* bar = b.bar;
        __builtin_amdgcn_s_waitcnt(0);
        unsigned nloc = b.st[0], nx = b.st[1];
        if (nloc == 0u) { xcd_barrier_complete(bar, b.x, nloc, nx); b.st[0] = nloc; b.st[1] = nx; }
        const unsigned old = xb_add(&bar[XB_XSUB(b.x)], 1u);
        const unsigned gen = old / nloc;
        if (old + 1u == (gen + 1u) * nloc) {
            __builtin_amdgcn_fence(__ATOMIC_RELEASE, "agent");
            asm volatile("s_waitcnt vmcnt(0)" ::: "memory");
            const unsigned og = xb_add(&bar[XB_TOP], 1u);
            const unsigned tg = og / nx;
            if (og + 1u == (tg + 1u) * nx) xb_add(&bar[XB_TOPGEN], 1u);
            else XB_SPIN(xb_ld(&bar[XB_TOPGEN]) == tg, bar);
            __builtin_amdgcn_fence(__ATOMIC_ACQUIRE, "agent");
            xb_add(&bar[XB_XGEN(b.x)], 1u);
            asm volatile("s_waitcnt vmcnt(0)" ::: "memory");
        } else {
            XB_SPIN(xb_ld(&bar[XB_XGEN(b.x)]) == gen, bar);
            __builtin_amdgcn_fence(__ATOMIC_ACQUIRE, "agent");
            asm volatile("s_waitcnt vmcnt(0)" ::: "memory");
        }
    }
    __syncthreads();
}

DI void phase_adaln(const Params& p, char* smem) {
  const int tid = get_tid();
  float* sc = (float*)smem;
  float* red = sc + 9 * 1024;
  const float* c = p.in[1];
  const float* cctx = p.in[3];
  const float* w_ada = p.in[4];
  const float* b_ada = p.in[5];
  float* mods = (float*)(p.ws + OFF_MODS);
  for (int i = tid; i < 9 * 1024; i += NT) {
    int j = i >> 10, k = i & 1023;
    float v = j < 8 ? c[j * 1024 + k] : cctx[k];
    sc[i] = siluf(v);
  }
  __syncthreads();
  for (int item = blockIdx.x; item < 192; item += gridDim.x) {
    const int l = item / 96, n0 = (item % 96) * 64;
    const int kg = tid >> 6, nn = tid & 63;
    float acc[9];
#pragma unroll
    for (int j = 0; j < 9; ++j) acc[j] = 0.f;
    const float* w = w_ada + (size_t)l * 1024 * 6144 + n0 + nn;
#pragma unroll 1
    for (int k = kg * 128; k < kg * 128 + 128; k += 32) {
      float wv[32];
#pragma unroll
      for (int q = 0; q < 32; ++q) wv[q] = w[(size_t)(k + q) * 6144];
#pragma unroll
      for (int j = 0; j < 9; ++j) {
#pragma unroll
        for (int q4 = 0; q4 < 8; ++q4) {
          const float4 s0 = *(const float4*)(sc + j * 1024 + k + 4 * q4);
          acc[j] += s0.x * wv[4 * q4] + s0.y * wv[4 * q4 + 1] + s0.z * wv[4 * q4 + 2] + s0.w * wv[4 * q4 + 3];
        }
      }
    }
#pragma unroll
    for (int j = 0; j < 9; ++j) red[(kg * 64 + nn) * 9 + j] = acc[j];
    __syncthreads();
    for (int t2 = tid; t2 < 576; t2 += NT) {
      int j = t2 >> 6, n2 = t2 & 63;
      float s = b_ada[l * 6144 + n0 + n2];
#pragma unroll
      for (int g = 0; g < 8; ++g) s += red[(g * 64 + n2) * 9 + j];
      mods[((size_t)l * 9 + j) * 6144 + n0 + n2] = s;
    }
    __syncthreads();
  }
}

DI int srccol(int mode, int n) {
  if (mode == 0) return n;
  if (n < 2560) return n;
  if (n < 5632) return n + 32;
  if (n < 5664) return n - 3072;
  if (n < 5696) return n;
  return -1;
}
DI void convert_w(const float* src, int K, int Nsrc, u16* dst, int Npad, int mode, char* smem) {
  float* Tt = (float*)smem;
  const int tid = get_tid();
  const int kts = K >> 6;
  const int ntiles = kts * (Npad >> 6);
  const int lr = tid >> 4, lc = (tid & 15) * 4;
  float4 pre[2];
  auto tload = [&](int tile) {
    const int kt = tile % kts, nt = tile / kts;
    const int scn = srccol(mode, nt * 64 + lc);
#pragma unroll
    for (int i = 0; i < 2; ++i)
      pre[i] = scn >= 0 ? *(const float4*)(src + (size_t)(kt * 64 + lr + 32 * i) * Nsrc + scn) : make_float4(0.f, 0.f, 0.f, 0.f);
  };
  int tile = blockIdx.x;
  if (tile < ntiles) tload(tile);
  for (; tile < ntiles; tile += gridDim.x) {
    const int kt = tile % kts, nt = tile / kts;
#pragma unroll
    for (int i = 0; i < 2; ++i) *(float4*)(Tt + (lr + 32 * i) * 68 + lc) = pre[i];
    if (tile + (int)gridDim.x < ntiles) tload(tile + gridDim.x);
    __syncthreads();
    {
      int nn = tid >> 3, kc = tid & 7;
      u32x4 o;
#pragma unroll
      for (int j = 0; j < 4; ++j)
        o[j] = pack2(Tt[(kc * 8 + 2 * j) * 68 + nn], Tt[(kc * 8 + 2 * j + 1) * 68 + nn]);
      *(u32x4*)(dst + (size_t)(nt * 64 + nn) * K + kt * 64 + kc * 8) = o;
    }
    __syncthreads();
  }
}

template <bool HAS_DELTA, bool FINAL>
DI void norm_mod(const float* hc_src, const float* hl_src, float* hc_dst, float* hl_dst, const u16* delta,
                 const float* gate_mods, int gate_off, const float* g, const float* mods_l, int shoff, int scoff,
                 u16* u, int r0, const u16* slabs = nullptr) {
  const int tid = get_tid();
  const int lane = tid & 63;
  const int gw = blockIdx.x * (NT / 64) + (tid >> 6), nw = gridDim.x * (NT / 64);
  float4 nv[2][4];
  u32x2 ndv[2][4];
  auto rload = [&](int r) {
    const float* src = r < TC ? hc_src + (size_t)r * 1024 : hl_src + (size_t)(r - TC) * 1024;
#pragma unroll
    for (int q = 0; q < 2; ++q)
#pragma unroll
      for (int i = 0; i < 4; ++i) {
        const int col = i * 256 + lane * 4;
        nv[q][i] = *(const float4*)(src + q * 1024 + col);
        if (HAS_DELTA) {
          if (slabs != nullptr && r < TC) {
            float s0 = 0.f, s1 = 0.f, s2 = 0.f, s3 = 0.f;
#pragma unroll
            for (int sl = 0; sl < NSPLIT; ++sl) {
              const u32x2 t = *(const u32x2*)(slabs + (size_t)sl * TC * 1024 + (size_t)(r + q) * 1024 + col);
              s0 += bflo(t[0]); s1 += bfhi(t[0]); s2 += bflo(t[1]); s3 += bfhi(t[1]);
            }
            u32x2 pk = {pack2(s0, s1), pack2(s2, s3)};
            ndv[q][i] = pk;
          } else {
            ndv[q][i] = *(const u32x2*)(delta + (size_t)(r + q) * 1024 + col);
          }
        }
      }
  };
  int r = r0 + 2 * gw;
  if (r < TT) rload(r);
  for (; r < TT; r += 2 * nw) {
    const bool isctx = r < TC;
    const int j = isctx ? 8 : (r - TC) >> 12;
    const float* md = mods_l + j * 6144;
    float4 v[2][4], g4[4], sh[4], sc[4], gt[4];
    u32x2 dv[2][4];
#pragma unroll
    for (int q = 0; q < 2; ++q)
#pragma unroll
      for (int i = 0; i < 4; ++i) { v[q][i] = nv[q][i]; if (HAS_DELTA) dv[q][i] = ndv[q][i]; }
#pragma unroll
    for (int i = 0; i < 4; ++i) {
      const int col = i * 256 + lane * 4;
      g4[i] = *(const float4*)(g + col);
      if (HAS_DELTA) gt[i] = *(const float4*)(gate_mods + j * 6144 + gate_off + col);
      if (!FINAL) {
        sh[i] = *(const float4*)(md + shoff + col);
        sc[i] = *(const float4*)(md + scoff + col);
      }
    }
    if (r + 2 * nw < TT) rload(r + 2 * nw);
    float ss[2] = {0.f, 0.f};
#pragma unroll
    for (int q = 0; q < 2; ++q)
#pragma unroll
      for (int i = 0; i < 4; ++i) {
        const int col = i * 256 + lane * 4;
        if (HAS_DELTA) {
          v[q][i].x += gt[i].x * bflo(dv[q][i][0]); v[q][i].y += gt[i].y * bfhi(dv[q][i][0]);
          v[q][i].z += gt[i].z * bflo(dv[q][i][1]); v[q][i].w += gt[i].w * bfhi(dv[q][i][1]);
          if (!FINAL) {
            float* dst = isctx ? hc_dst + (size_t)(r + q) * 1024 : hl_dst + (size_t)(r + q - TC) * 1024;
            *(float4*)(dst + col) = v[q][i];
          }
        }
        ss[q] += v[q][i].x * v[q][i].x + v[q][i].y * v[q][i].y + v[q][i].z * v[q][i].z + v[q][i].w * v[q][i].w;
      }
#pragma unroll
    for (int o = 32; o >= 1; o >>= 1) { ss[0] += __shfl_xor(ss[0], o); ss[1] += __shfl_xor(ss[1], o); }
#pragma unroll
    for (int q = 0; q < 2; ++q) {
      const float rstd = rsqrtf(ss[q] * (1.f / 1024.f) + EPS);
#pragma unroll
      for (int i = 0; i < 4; ++i) {
        const int col = i * 256 + lane * 4;
        if (FINAL) {
          float4 o = {v[q][i].x * rstd * g4[i].x, v[q][i].y * rstd * g4[i].y, v[q][i].z * rstd * g4[i].z, v[q][i].w * rstd * g4[i].w};
          *(float4*)(hl_dst + (size_t)(r + q - TC) * 1024 + col) = o;
        } else {
          float a0 = v[q][i].x * rstd * g4[i].x * (1.f + sc[i].x) + sh[i].x;
          float a1 = v[q][i].y * rstd * g4[i].y * (1.f + sc[i].y) + sh[i].y;
          float a2 = v[q][i].z * rstd * g4[i].z * (1.f + sc[i].z) + sh[i].z;
          float a3 = v[q][i].w * rstd * g4[i].w * (1.f + sc[i].w) + sh[i].w;
          u32x2 o = {pack2(a0, a1), pack2(a2, a3)};
          *(u32x2*)(u + (size_t)(r + q) * 1024 + col) = o;
        }
      }
    }
  }
}

enum { EPI_IN = 0, EPI_DELTA = 1, EPI_FF1 = 2 };

constexpr int G_HT = 128 * 64;
DI int g_lds_byte(int r, int c) {
  int st = (r >> 4) * 2 + (c >> 5), rr = r & 15, cc = c & 31, ob = rr * 64 + cc * 2;
  return st * 1024 + (ob ^ (((ob >> 9) & 1) << 5));
}
DI void g_stage_rc(int b, int& R, int& C) {
  int st = b / 1024, sb = b % 1024, swz = sb ^ (((sb >> 9) & 1) << 5);
  R = (st >> 1) * 16 + swz / 64;
  C = (st & 1) * 32 + (swz % 64) / 2;
}
typedef float f32x4v __attribute__((ext_vector_type(4)));

template <int EPI>
DI void gemm256_phase(const Params& p, int l, const u16* A0, int lda0, const u16* A1, int lda1, int ksplit_kt,
                      const u16* Bt, int K, int mt0, int mt1, int nN, char* smem, int nsplit = 1, u16* slabs = nullptr) {
  u16* shm = (u16*)smem;
  const int tid = get_tid();
  const int wid = tid >> 6, lane = tid & 63, wr = wid >> 2, wc = wid & 3, fr = lane & 15, fq = lane >> 4;
  const int nctx = nsplit > 1 ? 8 * nN * nsplit : 0;
  const int mlat0 = nsplit > 1 ? 8 : mt0;
  const int nM = mt1 - mlat0, nwg = nM * nN, nt = K >> 6, nunits = nctx + nwg;
  int sr0, sc0;
  g_stage_rc(tid * 16, sr0, sc0);
  const unsigned voffB = (unsigned)(sr0 * K + sc0) * 2u;
  const int laneoff = (fr * 64 + fq * 16) ^ ((fr >> 3) << 5);
  const char* aBase = (const char*)shm + wr * 8192 + laneoff;
  const char* bBase = (const char*)shm + 65536 + wc * 4096 + laneoff;
#define G_SA(b, h) (shm + ((b) * 2 + (h)) * G_HT)
#define G_SB(b, h) (shm + (4 + (b) * 2 + (h)) * G_HT)
#define G_STAGE_B(P, br, kt) do { const char* _g = (const char*)Bt + ((size_t)(br) * K + (size_t)((kt) + kbase) * 64) * 2; \
    __builtin_amdgcn_global_load_lds((const unsigned*)(_g + voffB), (unsigned*)((char*)(P) + tid * 16), 16, 0, 0); \
    __builtin_amdgcn_global_load_lds((const unsigned*)(_g + (size_t)K * 128 + voffB), (unsigned*)((char*)(P) + tid * 16 + 8192), 16, 0, 0); } while (0)
#define G_STAGE_A(P, br, kt) do { const u16* _b; int _ld, _kk; const int _kt = (kt) + kbase; \
    if (_kt < ksplit_kt) { _b = A0; _ld = lda0; _kk = _kt; } else { _b = A1; _ld = lda1; _kk = _kt - ksplit_kt; } \
    const char* _g = (const char*)_b + ((size_t)(br) * _ld + (size_t)_kk * 64) * 2; \
    const unsigned _vo = (unsigned)(sr0 * _ld + sc0) * 2u; \
    __builtin_amdgcn_global_load_lds((const unsigned*)(_g + _vo), (unsigned*)((char*)(P) + tid * 16), 16, 0, 0); \
    __builtin_amdgcn_global_load_lds((const unsigned*)(_g + (size_t)_ld * 128 + _vo), (unsigned*)((char*)(P) + tid * 16 + 8192), 16, 0, 0); } while (0)
#define G_LDA(dst, b, h) _Pragma("unroll") for (int m = 0; m < 4; ++m) _Pragma("unroll") for (int k = 0; k < 2; ++k) \
    dst[m][k] = *reinterpret_cast<const bf16x8*>(aBase + ((b) * 2 + (h)) * 16384 + (m * 2 + k) * 1024)
#define G_LDB(dst, b, h) _Pragma("unroll") for (int n = 0; n < 2; ++n) _Pragma("unroll") for (int k = 0; k < 2; ++k) \
    dst[n][k] = *reinterpret_cast<const bf16x8*>(bBase + ((b) * 2 + (h)) * 16384 + (n * 2 + k) * 1024)
#define G_MMA(ai, bj, At_, Bt_) do { __builtin_amdgcn_s_setprio(1); \
    _Pragma("unroll") for (int m = 0; m < 4; ++m) _Pragma("unroll") for (int n = 0; n < 2; ++n) _Pragma("unroll") for (int k = 0; k < 2; ++k) \
      acc[ai][bj][m][n] = __builtin_amdgcn_mfma_f32_16x16x32_bf16(Bt_[n][k], At_[m][k], acc[ai][bj][m][n], 0, 0, 0); \
    __builtin_amdgcn_s_setprio(0); } while (0)
#define G_WAIT_V(n) asm volatile("s_waitcnt vmcnt(" #n ")" ::: "memory")
#define G_WAIT_L(n) asm volatile("s_waitcnt lgkmcnt(" #n ")" ::: "memory")
#define G_BAR __builtin_amdgcn_s_barrier()
#define G_SCHED __builtin_amdgcn_sched_barrier(0)
  auto tile_rc = [&](int unit_, int& brow_, int& bcol_, int& kbase_, int& ntl_, int& dsel_) {
    if (unit_ < nctx) {
      const int ks = unit_ % nsplit, t_ = unit_ / nsplit;
      brow_ = (t_ & 7) * 256; bcol_ = (t_ >> 3) * 256;
      ntl_ = nt / nsplit; kbase_ = ks * ntl_; dsel_ = ks + 1;
      return;
    }
    kbase_ = 0; ntl_ = nt; dsel_ = 0;
    int wgid = unit_ - nctx;
    { int q = nwg / 8, rq = nwg % 8, xcd = wgid % 8, off = wgid / 8;
      wgid = (xcd < rq ? xcd * (q + 1) : rq * (q + 1) + (xcd - rq) * q) + off; }
    const int nig = 8 * nN, gid = wgid / nig, fm = gid * 8, gsz = min(nM - fm, 8);
    const int pm = fm + ((wgid % nig) % gsz), pn = (wgid % nig) / gsz;
    brow_ = (mlat0 + pm) * 256; bcol_ = pn * 256;
  };
  bool pre = false;
  for (int tile = blockIdx.x; tile < nunits; tile += gridDim.x) {
    int brow, bcol, kbase, ntl, dsel;
    tile_rc(tile, brow, bcol, kbase, ntl, dsel);
    f32x4v acc[2][2][4][2];
#pragma unroll
    for (int a = 0; a < 2; ++a)
#pragma unroll
      for (int b2 = 0; b2 < 2; ++b2)
#pragma unroll
        for (int m = 0; m < 4; ++m)
#pragma unroll
          for (int n = 0; n < 2; ++n) { f32x4v z = {0.f, 0.f, 0.f, 0.f}; acc[a][b2][m][n] = z; }
    bf16x8 At[4][2], B0[2][2], B1[2][2];
    if (!pre) {
      G_STAGE_B(G_SB(0, 0), bcol, 0); G_STAGE_A(G_SA(0, 0), brow, 0);
      G_STAGE_B(G_SB(0, 1), bcol + 128, 0); G_STAGE_A(G_SA(0, 1), brow + 128, 0);
    }
    if (wr == 1) G_BAR;
    G_WAIT_V(4); G_BAR;
    G_STAGE_B(G_SB(1, 0), bcol, 1); G_STAGE_A(G_SA(1, 0), brow, 1); G_STAGE_B(G_SB(1, 1), bcol + 128, 1);
    G_WAIT_V(6); G_BAR;
    for (int t = 0; t < ntl - 2; t += 2) {
      G_LDB(B0, 0, 0); G_SCHED; G_LDA(At, 0, 0); G_STAGE_A(G_SA(1, 1), brow + 128, t + 1);
      G_WAIT_L(8); G_BAR; G_WAIT_L(0); G_MMA(0, 0, At, B0); G_BAR; G_SCHED;
      G_LDB(B1, 0, 1); G_STAGE_B(G_SB(0, 0), bcol, t + 2);
      G_BAR; G_WAIT_L(0); G_MMA(0, 1, At, B1); G_BAR;
      G_LDA(At, 0, 1); G_STAGE_A(G_SA(0, 0), brow, t + 2);
      G_BAR; G_WAIT_L(0); G_MMA(1, 0, At, B0); G_BAR; G_SCHED;
      G_STAGE_B(G_SB(0, 1), bcol + 128, t + 2);
      G_WAIT_V(6); G_BAR; G_MMA(1, 1, At, B1); G_BAR;
      G_LDB(B0, 1, 0); G_SCHED; G_LDA(At, 1, 0); G_STAGE_A(G_SA(0, 1), brow + 128, t + 2);
      G_WAIT_L(8); G_BAR; G_WAIT_L(0); G_MMA(0, 0, At, B0); G_BAR; G_SCHED;
      G_LDB(B1, 1, 1); G_STAGE_B(G_SB(1, 0), bcol, t + 3);
      G_BAR; G_WAIT_L(0); G_MMA(0, 1, At, B1); G_BAR;
      G_LDA(At, 1, 1); G_STAGE_A(G_SA(1, 0), brow, t + 3);
      G_BAR; G_WAIT_L(0); G_MMA(1, 0, At, B0); G_BAR; G_SCHED;
      G_STAGE_B(G_SB(1, 1), bcol + 128, t + 3);
      G_WAIT_V(6); G_BAR; G_MMA(1, 1, At, B1); G_BAR;
    }
    { G_LDB(B0, 0, 0); G_LDA(At, 0, 0); G_STAGE_A(G_SA(1, 1), brow + 128, ntl - 1);
      G_BAR; G_WAIT_L(0); G_MMA(0, 0, At, B0); G_BAR;
      G_LDB(B1, 0, 1); G_BAR; G_WAIT_L(0); G_MMA(0, 1, At, B1); G_BAR;
      G_LDA(At, 0, 1); G_WAIT_V(4); G_BAR; G_WAIT_L(0); G_MMA(1, 0, At, B0); G_MMA(1, 1, At, B1); G_BAR; }
    { G_LDB(B0, 1, 0); G_LDA(At, 1, 0); G_WAIT_V(2); G_BAR; G_WAIT_L(0); G_MMA(0, 0, At, B0); G_BAR;
      G_LDB(B1, 1, 1); G_WAIT_V(0); G_BAR; G_WAIT_L(0); G_MMA(0, 1, At, B1); G_BAR;
      G_LDA(At, 1, 1); G_BAR; G_WAIT_L(0); G_MMA(1, 0, At, B0); G_MMA(1, 1, At, B1); G_BAR; }
    if (wr == 0) G_BAR;
    G_SCHED;
    {
      const int tid2 = get_tid();
      const int wid2 = tid2 >> 6, lane2 = tid2 & 63;
      const int rbase = brow + (wid2 >> 2) * 64 + (lane2 & 15);
      const int cbase = bcol + (wid2 & 3) * 32 + (lane2 >> 4) * 4;
      unsigned char* ws = p.ws;
      const bool staged = !(EPI == EPI_IN && bcol == 5632);
      if (staged) {
        __syncthreads();
        typedef __attribute__((address_space(3))) char lds_char;
        lds_char* area0 = (lds_char*)((char*)shm + 32768);
        lds_char* area1 = (lds_char*)((char*)shm + 98304);
        const int wr2 = wid2 >> 2, wc2 = wid2 & 3, fr2 = lane2 & 15, fq2 = lane2 >> 4;
        const int wbase = (wr2 * 64 + fr2) * 256 + (((wc2 * 4 + (fq2 >> 1)) ^ fr2) << 4) + (fq2 & 1) * 8;
        const int rrow0 = tid2 >> 4, rG = tid2 & 15;
        const int rbase0 = rrow0 * 256 + ((rG ^ (rrow0 & 15)) << 4);
        u16* qdst[2]; int qld[2], qc0[2]; float qscale[2];
#pragma unroll
        for (int bj = 0; bj < 2; ++bj) {
          qscale[bj] = 1.f;
          if (EPI == EPI_IN) {
            const int nt128 = (bcol >> 7) + bj;
            int coff;
            if (nt128 < 8) { qdst[bj] = (u16*)(ws + OFF_C); qld[bj] = 1024; coff = 0; }
            else if (nt128 < 20) { qdst[bj] = (u16*)(ws + OFF_A); qld[bj] = 1536; coff = 1024; }
            else if (nt128 < 28) { qdst[bj] = (u16*)(ws + OFF_D); qld[bj] = 1024; coff = 2560; qscale[bj] = nt128 < 24 ? 0.08838834764831845f : 1.f; }
            else if (nt128 < 36) { qdst[bj] = (u16*)(ws + OFF_E); qld[bj] = 1024; coff = 3584; }
            else { qdst[bj] = (u16*)(ws + OFF_F); qld[bj] = 1024; coff = 4608; }
            qc0[bj] = bcol + bj * 128 - coff;
          } else if (EPI == EPI_FF1) {
            qdst[bj] = (u16*)(ws + OFF_C); qld[bj] = 4096; qc0[bj] = bcol + bj * 128;
          } else {
            qdst[bj] = dsel == 0 ? (u16*)(ws + OFF_A) : slabs + (size_t)(dsel - 1) * TC * 1024;
            qld[bj] = 1024; qc0[bj] = bcol + bj * 128;
          }
        }
#pragma unroll
        for (int ai = 0; ai < 2; ++ai) {
#pragma unroll
          for (int bj = 0; bj < 2; ++bj)
#pragma unroll
            for (int m = 0; m < 4; ++m)
#pragma unroll
              for (int n = 0; n < 2; ++n) {
                const f32x4v v = acc[ai][bj][m][n];
                u32x2 o;
                if (EPI == EPI_FF1) {
                  float r0 = fmaxf(v[0], 0.f), r1 = fmaxf(v[1], 0.f), r2 = fmaxf(v[2], 0.f), r3 = fmaxf(v[3], 0.f);
                  o[0] = pack2(r0 * r0, r1 * r1); o[1] = pack2(r2 * r2, r3 * r3);
                } else {
                  const float sc = qscale[bj];
                  o[0] = pack2(v[0] * sc, v[1] * sc); o[1] = pack2(v[2] * sc, v[3] * sc);
                }
                *(__attribute__((address_space(3))) u32x2*)((bj ? area1 : area0) + ((wbase ^ (n << 5)) + m * 4096)) = o;
              }
          __syncthreads();
#pragma unroll
          for (int bj = 0; bj < 2; ++bj)
#pragma unroll
            for (int i = 0; i < 4; ++i) {
              const u32x4 val = *(const __attribute__((address_space(3))) u32x4*)((bj ? area1 : area0) + rbase0 + i * 8192);
              *(u32x4*)((char*)qdst[bj] + (unsigned)((brow + ai * 128 + rrow0 + 32 * i) * qld[bj] + qc0[bj] + rG * 8) * 2u) = val;
            }
          __syncthreads();
        }
      } else if (EPI == EPI_IN) {
#pragma unroll
        for (int bj = 0; bj < 2; ++bj) {
          const int nt128 = (bcol >> 7) + bj;
          if (nt128 < 44) {
            u16* dst; int ld, coff; float scale = 1.f;
            if (nt128 < 8) { dst = (u16*)(ws + OFF_C); ld = 1024; coff = 0; }
            else if (nt128 < 20) { dst = (u16*)(ws + OFF_A); ld = 1536; coff = 1024; }
            else if (nt128 < 28) { dst = (u16*)(ws + OFF_D); ld = 1024; coff = 2560; scale = nt128 < 24 ? 0.08838834764831845f : 1.f; }
            else if (nt128 < 36) { dst = (u16*)(ws + OFF_E); ld = 1024; coff = 3584; }
            else { dst = (u16*)(ws + OFF_F); ld = 1024; coff = 4608; }
#pragma unroll
            for (int ai = 0; ai < 2; ++ai)
#pragma unroll
              for (int m = 0; m < 4; ++m)
#pragma unroll
                for (int n = 0; n < 2; ++n) {
                  const int row = rbase + ai * 128 + m * 16, col = cbase + bj * 128 + n * 16 - coff;
                  const f32x4v v = acc[ai][bj][m][n];
                  u32x2 o = {pack2(v[0] * scale, v[1] * scale), pack2(v[2] * scale, v[3] * scale)};
                  *(u32x2*)((char*)dst + (unsigned)(row * ld + col) * 2u) = o;
                }
          } else if (nt128 == 44) {
            float* dtp = (float*)(ws + OFF_DT);
            float* gap = (float*)(ws + OFF_GA);
            const float* dtb = p.in[10] + l * 32;
#pragma unroll
            for (int ai = 0; ai < 2; ++ai)
#pragma unroll
              for (int m = 0; m < 4; ++m)
#pragma unroll
                for (int n = 0; n < 2; ++n) {
                  const int row = rbase + ai * 128 + m * 16, c0 = cbase + bj * 128 + n * 16 - 5632;
                  const f32x4v v = acc[ai][bj][m][n];
                  if (c0 < 32) {
                    float4 o;
                    float x0 = v[0] + dtb[c0], x1 = v[1] + dtb[c0 + 1], x2 = v[2] + dtb[c0 + 2], x3 = v[3] + dtb[c0 + 3];
                    o.x = x0 > 20.f ? x0 : __logf(1.f + __expf(x0));
                    o.y = x1 > 20.f ? x1 : __logf(1.f + __expf(x1));
                    o.z = x2 > 20.f ? x2 : __logf(1.f + __expf(x2));
                    o.w = x3 > 20.f ? x3 : __logf(1.f + __expf(x3));
                    *(float4*)(dtp + (size_t)row * 32 + c0) = o;
                  } else if (c0 < 64) {
                    float4 o = {v[0], v[1], v[2], v[3]};
                    *(float4*)(gap + (size_t)row * 32 + (c0 - 32)) = o;
                  }
                }
          }
        }
      } else if (EPI == EPI_FF1) {
        u16* dst = (u16*)(ws + OFF_C);
#pragma unroll
        for (int ai = 0; ai < 2; ++ai)
#pragma unroll
          for (int bj = 0; bj < 2; ++bj)
#pragma unroll
            for (int m = 0; m < 4; ++m)
#pragma unroll
              for (int n = 0; n < 2; ++n) {
                const int row = rbase + ai * 128 + m * 16, col = cbase + bj * 128 + n * 16;
                const f32x4v v = acc[ai][bj][m][n];
                float r0 = fmaxf(v[0], 0.f), r1 = fmaxf(v[1], 0.f), r2 = fmaxf(v[2], 0.f), r3 = fmaxf(v[3], 0.f);
                u32x2 o = {pack2(r0 * r0, r1 * r1), pack2(r2 * r2, r3 * r3)};
                *(u32x2*)((char*)dst + (unsigned)(row * 4096 + col) * 2u) = o;
              }
      } else {
        u16* dst = dsel == 0 ? (u16*)(ws + OFF_A) : slabs + (size_t)(dsel - 1) * TC * 1024;
#pragma unroll
        for (int ai = 0; ai < 2; ++ai)
#pragma unroll
          for (int bj = 0; bj < 2; ++bj)
#pragma unroll
            for (int m = 0; m < 4; ++m)
#pragma unroll
              for (int n = 0; n < 2; ++n) {
                const int row = rbase + ai * 128 + m * 16, col = cbase + bj * 128 + n * 16;
                const f32x4v v = acc[ai][bj][m][n];
                u32x2 o = {pack2(v[0], v[1]), pack2(v[2], v[3])};
                *(u32x2*)((char*)dst + (unsigned)(row * 1024 + col) * 2u) = o;
              }
      }
    }
    G_WAIT_V(0);
    G_BAR;
  }
}

DI int g_perm32(int rho) { const int n = rho >> 4, i = rho & 15; return 8 * (i >> 2) + 4 * n + (i & 3); }

template <int EPI>
DI void gemm_stream_phase(const Params& p, int l, const u16* A0, int lda0, const u16* A1, int lda1, int ksplit_kt,
                          const u16* Bt, int K, int mt0, int mt1, int nN, char* smem, int nsplit = 1, u16* slabs = nullptr) {
  u16* shm = (u16*)smem;
  const int tid = get_tid();
  const int wid = tid >> 6, lane = tid & 63, wr = wid >> 2, wc = wid & 3, fr = lane & 15, fq = lane >> 4;
  const int nctx = nsplit > 1 ? 8 * nN * nsplit : 0;
  const int mlat0 = nsplit > 1 ? 8 : mt0;
  const int nM = mt1 - mlat0, nwg = nM * nN, nt = K >> 6, nunits = nctx + nwg;
  int sr0, sc0;
  g_stage_rc(tid * 16, sr0, sc0);
  const int srb = (sr0 & ~31) + g_perm32(sr0 & 31);
  const unsigned voffB = (unsigned)(srb * K + sc0) * 2u;
  const int laneoff = (fr * 64 + fq * 16) ^ ((fr >> 3) << 5);
  const char* aBase = (const char*)shm + wr * 8192 + laneoff;
  const char* bBase = (const char*)shm + 65536 + wc * 4096 + laneoff;
#define S_SA(b, h) (shm + ((b) * 2 + (h)) * G_HT)
#define S_SB(b, h) (shm + (4 + (b) * 2 + (h)) * G_HT)
#define S_STAGE_B(P, brw, ktabs) do { const char* _g = (const char*)Bt + ((size_t)(brw) * K + (size_t)(ktabs) * 64) * 2; \
    __builtin_amdgcn_global_load_lds((const unsigned*)(_g + voffB), (unsigned*)((char*)(P) + tid * 16), 16, 0, 0); \
    __builtin_amdgcn_global_load_lds((const unsigned*)(_g + (size_t)K * 128 + voffB), (unsigned*)((char*)(P) + tid * 16 + 8192), 16, 0, 0); } while (0)
#define S_STAGE_A(P, brw, ktabs) do { const u16* _b; int _ld, _kk; const int _kt = (ktabs); \
    if (_kt < ksplit_kt) { _b = A0; _ld = lda0; _kk = _kt; } else { _b = A1; _ld = lda1; _kk = _kt - ksplit_kt; } \
    const char* _g = (const char*)_b + ((size_t)(brw) * _ld + (size_t)_kk * 64) * 2; \
    const unsigned _vo = (unsigned)(sr0 * _ld + sc0) * 2u; \
    __builtin_amdgcn_global_load_lds((const unsigned*)(_g + _vo), (unsigned*)((char*)(P) + tid * 16), 16, 0, 0); \
    __builtin_amdgcn_global_load_lds((const unsigned*)(_g + (size_t)_ld * 128 + _vo), (unsigned*)((char*)(P) + tid * 16 + 8192), 16, 0, 0); } while (0)
#define S_LDA(dst, b, h) _Pragma("unroll") for (int m = 0; m < 4; ++m) _Pragma("unroll") for (int k = 0; k < 2; ++k) \
    dst[m][k] = *reinterpret_cast<const bf16x8*>(aBase + ((b) * 2 + (h)) * 16384 + (m * 2 + k) * 1024)
#define S_LDB(dst, b, h) _Pragma("unroll") for (int n = 0; n < 2; ++n) _Pragma("unroll") for (int k = 0; k < 2; ++k) \
    dst[n][k] = *reinterpret_cast<const bf16x8*>(bBase + ((b) * 2 + (h)) * 16384 + (n * 2 + k) * 1024)
#define S_MMA(ai, bj, At_, Bt_) do { __builtin_amdgcn_s_setprio(1); \
    _Pragma("unroll") for (int m = 0; m < 4; ++m) _Pragma("unroll") for (int n = 0; n < 2; ++n) _Pragma("unroll") for (int k = 0; k < 2; ++k) \
      acc[ai][bj][m][n] = __builtin_amdgcn_mfma_f32_16x16x32_bf16(Bt_[n][k], At_[m][k], acc[ai][bj][m][n], 0, 0, 0); \
    __builtin_amdgcn_s_setprio(0); } while (0)
  auto unit_rc = [&](int unit_, int& brow_, int& bcol_, int& kbase_, int& ntl_, int& dsel_) {
    if (unit_ < nctx) {
      const int ks = unit_ % nsplit, t_ = unit_ / nsplit;
      brow_ = (t_ & 7) * 256; bcol_ = (t_ >> 3) * 256;
      ntl_ = nt / nsplit; kbase_ = ks * ntl_; dsel_ = ks + 1;
      return;
    }
    kbase_ = 0; ntl_ = nt; dsel_ = 0;
    int wgid = unit_ - nctx;
    { int q = nwg / 8, rq = nwg % 8, xcd = wgid % 8, off = wgid / 8;
      wgid = (xcd < rq ? xcd * (q + 1) : rq * (q + 1) + (xcd - rq) * q) + off; }
    const int nig = 8 * nN, gid = wgid / nig, fm = gid * 8, gsz = min(nM - fm, 8);
    const int pm = fm + ((wgid % nig) % gsz), pn = (wgid % nig) / gsz;
    brow_ = (mlat0 + pm) * 256; bcol_ = pn * 256;
  };
  int unit = blockIdx.x;
  if (unit >= nunits) return;
  int brow, bcol, kbase, ntl, dsel;
  unit_rc(unit, brow, bcol, kbase, ntl, dsel);
  f32x4v acc[2][2][4][2];
#pragma unroll
  for (int a = 0; a < 2; ++a)
#pragma unroll
    for (int b2 = 0; b2 < 2; ++b2)
#pragma unroll
      for (int m = 0; m < 4; ++m)
#pragma unroll
        for (int n = 0; n < 2; ++n) { f32x4v z = {0.f, 0.f, 0.f, 0.f}; acc[a][b2][m][n] = z; }
  bf16x8 At[4][2], B0[2][2], B1[2][2];
  S_STAGE_B(S_SB(0, 0), bcol, kbase); S_STAGE_A(S_SA(0, 0), brow, kbase);
  S_STAGE_B(S_SB(0, 1), bcol + 128, kbase); S_STAGE_A(S_SA(0, 1), brow + 128, kbase);
  if (wr == 1) G_BAR;
  G_WAIT_V(4); G_BAR;
  S_STAGE_B(S_SB(1, 0), bcol, kbase + 1); S_STAGE_A(S_SA(1, 0), brow, kbase + 1); S_STAGE_B(S_SB(1, 1), bcol + 128, kbase + 1);
  G_WAIT_V(6); G_BAR;
  for (;;) {
    const bool has_next = unit + (int)gridDim.x < nunits;
    int nbrow = brow, nbcol = bcol, nkb = kbase, nntl = ntl, ndsel = dsel;
    if (has_next) unit_rc(unit + gridDim.x, nbrow, nbcol, nkb, nntl, ndsel);
#pragma unroll 1
    for (int t = 0; t < ntl; t += 2) {
      const bool last = (t == ntl - 2);
      const int r2 = last ? nbrow : brow, c2 = last ? nbcol : bcol;
      const int k1 = kbase + t + 1, k2 = last ? nkb : kbase + t + 2, k3 = k2 + 1;
      G_LDB(B0, 0, 0); G_SCHED; G_LDA(At, 0, 0); S_STAGE_A(S_SA(1, 1), brow + 128, k1);
      G_WAIT_L(8); G_BAR; G_WAIT_L(0); S_MMA(0, 0, At, B0); G_BAR; G_SCHED;
      G_LDB(B1, 0, 1); S_STAGE_B(S_SB(0, 0), c2, k2);
      G_BAR; G_WAIT_L(0); S_MMA(0, 1, At, B1); G_BAR;
      G_LDA(At, 0, 1); S_STAGE_A(S_SA(0, 0), r2, k2);
      G_BAR; G_WAIT_L(0); S_MMA(1, 0, At, B0); G_BAR; G_SCHED;
      S_STAGE_B(S_SB(0, 1), c2 + 128, k2);
      G_WAIT_V(6); G_BAR; S_MMA(1, 1, At, B1); G_BAR;
      G_LDB(B0, 1, 0); G_SCHED; G_LDA(At, 1, 0); S_STAGE_A(S_SA(0, 1), r2 + 128, k2);
      G_WAIT_L(8); G_BAR; G_WAIT_L(0); S_MMA(0, 0, At, B0); G_BAR; G_SCHED;
      G_LDB(B1, 1, 1); S_STAGE_B(S_SB(1, 0), c2, k3);
      G_BAR; G_WAIT_L(0); S_MMA(0, 1, At, B1); G_BAR;
      G_LDA(At, 1, 1); S_STAGE_A(S_SA(1, 0), r2, k3);
      G_BAR; G_WAIT_L(0); S_MMA(1, 0, At, B0); G_BAR; G_SCHED;
      S_STAGE_B(S_SB(1, 1), c2 + 128, k3);
      G_WAIT_V(6); G_BAR; S_MMA(1, 1, At, B1); G_BAR;
    }
    G_SCHED;
    {
      const int tid2 = get_tid();
      const int wid2 = tid2 >> 6, lane2 = tid2 & 63;
      const int rbase = brow + (wid2 >> 2) * 64 + (lane2 & 15);
      const int cbase = bcol + (wid2 & 3) * 32 + (lane2 >> 4) * 8;
      unsigned char* ws = p.ws;
      if (EPI == EPI_IN && bcol == 5632) {
        const int c0 = cbase - 5632;
        float* dtp = (float*)(ws + OFF_DT);
        float* gap = (float*)(ws + OFF_GA);
        const float* dtb = p.in[10] + l * 32;
        if (c0 < 64) {
#pragma unroll
          for (int ai = 0; ai < 2; ++ai)
#pragma unroll
            for (int m = 0; m < 4; ++m) {
              const int row = rbase + ai * 128 + m * 16;
#pragma unroll
              for (int n = 0; n < 2; ++n) {
                const f32x4v v = acc[ai][0][m][n];
                const int cc = c0 + 4 * n;
                if (c0 < 32) {
                  float4 o;
                  float x0 = v[0] + dtb[cc], x1 = v[1] + dtb[cc + 1], x2 = v[2] + dtb[cc + 2], x3 = v[3] + dtb[cc + 3];
                  o.x = x0 > 20.f ? x0 : __logf(1.f + __expf(x0));
                  o.y = x1 > 20.f ? x1 : __logf(1.f + __expf(x1));
                  o.z = x2 > 20.f ? x2 : __logf(1.f + __expf(x2));
                  o.w = x3 > 20.f ? x3 : __logf(1.f + __expf(x3));
                  *(float4*)(dtp + (size_t)row * 32 + cc) = o;
                } else {
                  float4 o = {v[0], v[1], v[2], v[3]};
                  *(float4*)(gap + (size_t)row * 32 + (cc - 32)) = o;
                }
              }
            }
        }
      } else {
        u16* qdst[2]; int qld[2], qc0[2]; float qscale[2];
#pragma unroll
        for (int bj = 0; bj < 2; ++bj) {
          qscale[bj] = 1.f;
          if (EPI == EPI_IN) {
            const int nt128 = (bcol >> 7) + bj;
            int coff;
            if (nt128 < 8) { qdst[bj] = (u16*)(ws + OFF_C); qld[bj] = 1024; coff = 0; }
            else if (nt128 < 20) { qdst[bj] = (u16*)(ws + OFF_A); qld[bj] = 1536; coff = 1024; }
            else if (nt128 < 28) { qdst[bj] = (u16*)(ws + OFF_D); qld[bj] = 1024; coff = 2560; qscale[bj] = nt128 < 24 ? 0.08838834764831845f : 1.f; }
            else if (nt128 < 36) { qdst[bj] = (u16*)(ws + OFF_E); qld[bj] = 1024; coff = 3584; }
            else { qdst[bj] = (u16*)(ws + OFF_F); qld[bj] = 1024; coff = 4608; }
            qc0[bj] = cbase + bj * 128 - coff;
          } else if (EPI == EPI_FF1) {
            qdst[bj] = (u16*)(ws + OFF_C); qld[bj] = 4096; qc0[bj] = cbase + bj * 128;
          } else {
            qdst[bj] = dsel == 0 ? (u16*)(ws + OFF_A) : slabs + (size_t)(dsel - 1) * TC * 1024;
            qld[bj] = 1024; qc0[bj] = cbase + bj * 128;
          }
        }
#pragma unroll
        for (int ai = 0; ai < 2; ++ai)
#pragma unroll
          for (int m = 0; m < 4; ++m) {
            const int row = rbase + ai * 128 + m * 16;
#pragma unroll
            for (int bj = 0; bj < 2; ++bj) {
              const f32x4v v0 = acc[ai][bj][m][0], v1 = acc[ai][bj][m][1];
              u32x4 o;
              if (EPI == EPI_FF1) {
                float r0 = fmaxf(v0[0], 0.f), r1 = fmaxf(v0[1], 0.f), r2 = fmaxf(v0[2], 0.f), r3 = fmaxf(v0[3], 0.f);
                float r4 = fmaxf(v1[0], 0.f), r5 = fmaxf(v1[1], 0.f), r6 = fmaxf(v1[2], 0.f), r7 = fmaxf(v1[3], 0.f);
                o[0] = pack2(r0 * r0, r1 * r1); o[1] = pack2(r2 * r2, r3 * r3);
                o[2] = pack2(r4 * r4, r5 * r5); o[3] = pack2(r6 * r6, r7 * r7);
              } else {
                const float sc = qscale[bj];
                o[0] = pack2(v0[0] * sc, v0[1] * sc); o[1] = pack2(v0[2] * sc, v0[3] * sc);
                o[2] = pack2(v1[0] * sc, v1[1] * sc); o[3] = pack2(v1[2] * sc, v1[3] * sc);
              }
              *(u32x4*)((char*)qdst[bj] + (unsigned)(row * qld[bj] + qc0[bj]) * 2u) = o;
            }
          }
      }
    }
    G_SCHED;
    if (!has_next) break;
#pragma unroll
    for (int a = 0; a < 2; ++a)
#pragma unroll
      for (int b2 = 0; b2 < 2; ++b2)
#pragma unroll
        for (int m = 0; m < 4; ++m)
#pragma unroll
          for (int n = 0; n < 2; ++n) { f32x4v z = {0.f, 0.f, 0.f, 0.f}; acc[a][b2][m][n] = z; }
    unit += gridDim.x; brow = nbrow; bcol = nbcol; kbase = nkb; ntl = nntl; dsel = ndsel;
  }
  G_WAIT_V(0);
  if (wr == 0) G_BAR;
  G_BAR;
#undef S_SA
#undef S_SB
#undef S_STAGE_A
#undef S_STAGE_B
#undef S_LDA
#undef S_LDB
#undef S_MMA
}

DI void phase_conv(const Params& p, int l) {
  const u16* pre = (const u16*)(p.ws + OFF_A);
  u16* post = (u16*)(p.ws + OFF_B);
  const float* cw = p.in[8] + (size_t)l * 9 * 1536;
  const float* cb = p.in[9] + (size_t)l * 1536;
  const int total = (TT / 8) * 192;
  for (int id = blockIdx.x * NT + get_tid(); id < total; id += gridDim.x * NT) {
    const int cg8 = id % 192, run = id / 192, tok0 = run * 8, ch = cg8 * 8;
    int W, H, row, col0, base;
    if (tok0 < TC) { W = 256; H = 1; row = 0; col0 = tok0 & 255; base = tok0 & ~255; }
    else { int t = tok0 - TC; int rem = t & 4095; row = rem >> 6; col0 = rem & 63; W = 64; H = 64; base = TC + (t & ~4095); }
    float wgt[9][8];
#pragma unroll
    for (int t9 = 0; t9 < 9; ++t9) {
      float4 a = *(const float4*)(cw + t9 * 1536 + ch), b = *(const float4*)(cw + t9 * 1536 + ch + 4);
      wgt[t9][0] = a.x; wgt[t9][1] = a.y; wgt[t9][2] = a.z; wgt[t9][3] = a.w;
      wgt[t9][4] = b.x; wgt[t9][5] = b.y; wgt[t9][6] = b.z; wgt[t9][7] = b.w;
    }
    float bias[8];
    { float4 a = *(const float4*)(cb + ch), b = *(const float4*)(cb + ch + 4);
      bias[0] = a.x; bias[1] = a.y; bias[2] = a.z; bias[3] = a.w; bias[4] = b.x; bias[5] = b.y; bias[6] = b.z; bias[7] = b.w; }
    bool rv[3];
    const u16* rp[3];
    float win[3][3][8];
    const u32x4 zz = {0u, 0u, 0u, 0u};
    auto unpack8 = [](const u32x4 v, float (&o)[8]) {
#pragma unroll
      for (int j = 0; j < 4; ++j) { o[2 * j] = bflo(v[j]); o[2 * j + 1] = bfhi(v[j]); }
    };
#pragma unroll
    for (int dy = 0; dy < 3; ++dy) {
      int rr = row + dy - 1;
      rv[dy] = (rr >= 0 && rr < H);
      rp[dy] = pre + (size_t)(base + rr * W) * 1536 + ch;
      unpack8((rv[dy] && col0 - 1 >= 0) ? *(const u32x4*)(rp[dy] + (size_t)(col0 - 1) * 1536) : zz, win[dy][0]);
      unpack8(rv[dy] ? *(const u32x4*)(rp[dy] + (size_t)col0 * 1536) : zz, win[dy][1]);
    }
#pragma unroll
    for (int t = 0; t < 8; ++t) {
      const int col = col0 + t;
      float acc[8];
#pragma unroll
      for (int j = 0; j < 8; ++j) acc[j] = bias[j];
#pragma unroll
      for (int dy = 0; dy < 3; ++dy) {
        unpack8((rv[dy] && col + 1 < W) ? *(const u32x4*)(rp[dy] + (size_t)(col + 1) * 1536) : zz, win[dy][2]);
#pragma unroll
        for (int dx = 0; dx < 3; ++dx) {
#pragma unroll
          for (int j = 0; j < 8; ++j) acc[j] += wgt[dy * 3 + dx][j] * win[dy][dx][j];
        }
#pragma unroll
        for (int j = 0; j < 8; ++j) { win[dy][0][j] = win[dy][1][j]; win[dy][1][j] = win[dy][2][j]; }
      }
      u32x4 o;
#pragma unroll
      for (int j = 0; j < 4; ++j) o[j] = pack2(siluf(acc[2 * j]), siluf(acc[2 * j + 1]));
      *(u32x4*)(post + (size_t)(tok0 + t) * 1536 + ch) = o;
    }
  }
}

DI void ssd_item(const Params& p, int l, int item, char* smem) {
  const int tid = get_tid(), lane = tid & 63, w = tid >> 6, r = lane & 31, h = lane >> 5;
  const int b = (item & 15) >> 1, g = item & 1, hd = g * 8 + (item >> 5), ph = (item >> 4) & 1;
  u16* Bs = (u16*)smem;
  u16* Cs = Bs + 128 * 136;
  u16* Xs = Cs + 128 * 136;
  u16* Xdt = Xs + 128 * 40;
  u16* Xd2 = Xdt + 128 * 40;
  u16* Hs = Xd2 + 128 * 40;
  float* av = (float*)(Hs + 2 * 32 * 136);
  float* dtv = av + 128;
  float* Pex = dtv + 128;
  u16* xb = (u16*)(p.ws + OFF_B);
  u16* temp = (u16*)(p.ws + OFF_A) + (size_t)item * TEMP_ELEMS;
  const float* dtg = (const float*)(p.ws + OFF_DT);
  const int xcol = hd * 64 + ph * 32;
  const int brow0 = tid >> 4, bcc = tid & 15;
  const int xrow = tid >> 2, xcc = tid & 3;

#pragma unroll 1
  for (int dir = 0; dir < 2; ++dir) {
    const float Aneg = -__expf(p.in[11][l * 32 + dir * 16 + hd]) * 1.4426950408889634f;
    const float Dk = p.in[12][l * 32 + dir * 16 + hd];
    f32x16 hacc = zero16();
    auto pair_acc = [&](int I, int J, f32x16& Z) {
      const float a_i = av[I * 32 + r];
      f32x16 X = zero16();
#pragma unroll
      for (int kk = 0; kk < 8; ++kk) {
        bf16x8 a = ldfrag(Bs + (J * 32 + r) * 136 + kk * 16 + 8 * h);
        bf16x8 bq = ldfrag(Cs + (I * 32 + r) * 136 + kk * 16 + 8 * h);
        X = MFMA32(a, bq, X);
      }
#pragma unroll
      for (int reg = 0; reg < 16; ++reg) {
        const int jl = crow(reg, h);
        const float aj = av[J * 32 + jl];
        const bool keep = (J < I) || (jl <= r);
        X[reg] = keep ? X[reg] * __builtin_amdgcn_exp2f(a_i - aj) : 0.f;
      }
#pragma unroll
      for (int s = 0; s < 2; ++s) {
        bf16x8 xs = pack_step(X, s);
        bf16x8 pb = frag_tr(Xdt, 40, J * 32 + 16 * s + 4 * h, J * 32 + 16 * s + 8 + 4 * h, 0, lane);
        Z = MFMA32(xs, pb, Z);
      }
    };
    __syncthreads();
    for (int i = tid; i < 2 * 32 * 136; i += NT) Hs[i] = 0;
    u32x4 pB[4], pC[4], pX;
    float pdt = 0.f;
    auto chunk_base = [&](int step, int& tb, int& ltb) {
      if (step < 2) { int c = dir ? 1 - step : step; tb = b * 256 + c * 128; ltb = c * 128; }
      else { int c = step - 2; if (dir) c = 31 - c; tb = TC + b * 4096 + c * 128; ltb = 256 + c * 128; }
    };
    auto gload = [&](int step) {
      int tb, ltb;
      chunk_base(step, tb, ltb);
#pragma unroll
      for (int i = 0; i < 4; ++i) {
        const int row = brow0 + 32 * i;
        const int tr = dir ? 127 - row : row;
        const u16* src = xb + (size_t)(tb + tr) * 1536 + 1024 + g * 128 + bcc * 8;
        pB[i] = *(const u32x4*)src;
        pC[i] = *(const u32x4*)(src + 256);
      }
      {
        const int tr = dir ? 127 - xrow : xrow;
        pX = *(const u32x4*)(xb + (size_t)(tb + tr) * 1536 + xcol + xcc * 8);
      }
      if (tid < 128) {
        const int tr = dir ? 127 - tid : tid;
        pdt = dtg[(size_t)(tb + tr) * 32 + dir * 16 + hd];
      }
    };
    gload(0);
#pragma unroll 1
    for (int step = 0; step < 34; ++step) {
      int tb, ltb;
      chunk_base(step, tb, ltb);
      const int cur = step & 1;
      __syncthreads();
#pragma unroll
      for (int i = 0; i < 4; ++i) {
        const int row = brow0 + 32 * i;
        *(u32x4*)(Bs + row * 136 + bcc * 8) = pB[i];
        *(u32x4*)(Cs + row * 136 + bcc * 8) = pC[i];
      }
      *(u32x4*)(Xs + xrow * 40 + xcc * 8) = pX;
      if (tid < 128) dtv[tid] = pdt;
      const u32x4 xv = pX;
      if (step + 1 < 34) gload(step + 1);
      __syncthreads();
      {
        float v0 = dtv[2 * lane] * Aneg, v1 = dtv[2 * lane + 1] * Aneg;
        float s = v0 + v1, incl = s;
#pragma unroll
        for (int o = 1; o < 64; o <<= 1) {
          float t = __shfl_up(incl, o);
          if (lane >= o) incl += t;
        }
        float excl = incl - s;
        av[2 * lane] = excl + v0;
        av[2 * lane + 1] = excl + s;
      }
      {
        const float dd = dtv[xrow];
        const float e = dd * __builtin_amdgcn_exp2f(av[127] - av[xrow]);
        u32x4 o1, o2;
#pragma unroll
        for (int j = 0; j < 4; ++j) {
          float x0 = bflo(xv[j]), x1 = bfhi(xv[j]);
          o1[j] = pack2(x0 * dd, x1 * dd);
          o2[j] = pack2(x0 * e, x1 * e);
        }
        *(u32x4*)(Xdt + xrow * 40 + xcc * 8) = o1;
        *(u32x4*)(Xd2 + xrow * 40 + xcc * 8) = o2;
      }
      __syncthreads();
      f32x16 Z = zero16();
      u16 tprev[16];
      const int I = 3 - (w & 3);
      if (w < 4) {
        const u16* Hc = Hs + cur * 32 * 136;
        if (dir == 1) {
#pragma unroll
          for (int reg = 0; reg < 16; ++reg) {
            const int il = I * 32 + crow(reg, h);
            tprev[reg] = temp[(size_t)(ltb + 127 - il) * 32 + r];
          }
        }
#pragma unroll
        for (int kk = 0; kk < 8; ++kk) {
          bf16x8 a = ldfrag(Cs + (I * 32 + r) * 136 + kk * 16 + 8 * h);
          bf16x8 bq = ldfrag(Hc + r * 136 + kk * 16 + 8 * h);
          Z = MFMA32(a, bq, Z);
        }
#pragma unroll
        for (int reg = 0; reg < 16; ++reg) Z[reg] *= __builtin_amdgcn_exp2f(av[I * 32 + crow(reg, h)]);
        const int Jlo = I == 3 ? 2 : (I == 2 ? 1 : 0);
#pragma unroll 1
        for (int J = Jlo; J <= I; ++J) pair_acc(I, J, Z);
      } else {
        const int nt = w - 4;
        u16* Hn = Hs + (cur ^ 1) * 32 * 136;
        const float dec = __builtin_amdgcn_exp2f(av[127]);
#pragma unroll
        for (int reg = 0; reg < 16; ++reg) hacc[reg] *= dec;
#pragma unroll
        for (int kk = 0; kk < 8; ++kk) {
          bf16x8 a = frag_tr(Bs, 136, kk * 16 + 8 * h, kk * 16 + 8 * h + 4, nt * 32, lane);
          bf16x8 bq = frag_tr(Xd2, 40, kk * 16 + 8 * h, kk * 16 + 8 * h + 4, 0, lane);
          hacc = MFMA32(a, bq, hacc);
        }
#pragma unroll
        for (int gq = 0; gq < 4; ++gq) {
          u32x2 o = {pack2(hacc[4 * gq], hacc[4 * gq + 1]), pack2(hacc[4 * gq + 2], hacc[4 * gq + 3])};
          *(u32x2*)(Hn + r * 136 + nt * 32 + 8 * gq + 4 * h) = o;
        }
        if (w < 6) {
          const int Ih = 7 - w;
#pragma unroll 1
          for (int J = 0; J < Ih - 1; ++J) pair_acc(Ih, J, Z);
          float* P = Pex + (w - 4) * 32 * 33;
#pragma unroll
          for (int reg = 0; reg < 16; ++reg) P[crow(reg, h) * 33 + r] = Z[reg];
        }
      }
      __syncthreads();
      if (w < 4) {
        const float* P = Pex + w * 32 * 33;
#pragma unroll
        for (int reg = 0; reg < 16; ++reg) {
          const int il = I * 32 + crow(reg, h);
          float yv = Z[reg] + Dk * bf2f(Xs[il * 40 + r]);
          if (w < 2) yv += P[crow(reg, h) * 33 + r];
          const int tl = dir ? 127 - il : il;
          if (dir == 0) {
            temp[(size_t)(ltb + tl) * 32 + r] = f2bf(yv);
          } else {
            yv += bf2f(tprev[reg]);
            xb[(size_t)(tb + tl) * 1536 + xcol + r] = f2bf(yv);
          }
        }
      }
    }
  }
  __syncthreads();
}

DI void gla_item(const Params& p, int l, int item, char* smem) {
  const int tid = get_tid(), lane = tid & 63, w = tid >> 6, r = lane & 31, h = lane >> 5;
  const int sl = item >> 6, b = (item & 63) >> 3, hd = (item >> 1) & 3, dir = item & 1;
  u16* QdB = (u16*)smem;
  u16* KiB = QdB + 2 * 64 * 136;
  u16* VsB = KiB + 2 * 64 * 136;
  u16* Ss = VsB + 2 * 64 * 72;
  u16* gas = Ss + 64 * 136;
  float* seg = (float*)(gas + 64 * 16);
  float* blastB = seg + 2 * 128;
  float* Op = blastB + 2 * 128;
  const u16* qk = (const u16*)(p.ws + OFF_D);
  const u16* vb = (const u16*)(p.ws + OFF_E);
  const float* gag = (const float*)(p.ws + OFF_GA);
  const int vcol = hd * 256 + sl * 64;
  u16* obuf = (u16*)(p.ws + ((dir == 1 && hd >= 2) ? OFF_B : OFF_A));
  const int ocol = dir == 0 ? vcol : 1024 + (vcol & 511);
  const int It = w >> 2, dtl = w & 3;
  const int dcol = dtl * 32 + r;
  const int lrow0 = tid >> 4, lcc = tid & 15;
  const int vrow = tid >> 3, vcc = tid & 7;
  const int I = w >> 2, dvt = (w >> 1) & 1, role = w & 1;
  const int dtile = w >> 1, dv2 = w & 1;

  bf16x8 w2f;
  {
    const float* w2p = p.in[14] + ((size_t)(l * 2 + dir) * 16 + 8 * h) * 512 + hd * 128 + dcol;
    u32x4 t;
#pragma unroll
    for (int j = 0; j < 4; ++j) t[j] = pack2(w2p[(2 * j) * 512], w2p[(2 * j + 1) * 512]);
    w2f = __builtin_bit_cast(bf16x8, t);
  }
  const float b2v = p.in[15][(l * 2 + dir) * 512 + hd * 128 + dcol];
  f32x16 sacc = zero16();
  __syncthreads();
  for (int i = tid; i < 64 * 136; i += NT) Ss[i] = 0;
  u32x4 pq[2], pk[2], pv;
  float pga[2];
  auto chunk_base = [&](int step) {
    int tb;
    if (step < 4) { int c = dir ? 3 - step : step; tb = b * 256 + c * 64; }
    else { int c = step - 4; if (dir) c = 63 - c; tb = TC + b * 4096 + c * 64; }
    return tb;
  };
  auto gload = [&](int step) {
    const int tb = chunk_base(step);
#pragma unroll
    for (int i = 0; i < 2; ++i) {
      const int row = lrow0 + 32 * i;
      const int tr = dir ? 63 - row : row;
      const u16* src = qk + (size_t)(tb + tr) * 1024 + hd * 128 + lcc * 8;
      pq[i] = *(const u32x4*)src;
      pk[i] = *(const u32x4*)(src + 512);
      pga[i] = gag[(size_t)(tb + tr) * 32 + dir * 16 + lcc];
    }
    {
      const int tr = dir ? 63 - vrow : vrow;
      pv = *(const u32x4*)(vb + (size_t)(tb + tr) * 1024 + vcol + vcc * 8);
    }
  };
  auto fill = [&](int buf) {
    u16* Qd = QdB + buf * 64 * 136;
    u16* Ki = KiB + buf * 64 * 136;
#pragma unroll
    for (int i = 0; i < 2; ++i) {
      const int row = lrow0 + 32 * i;
      *(u32x4*)(Qd + row * 136 + lcc * 8) = pq[i];
      *(u32x4*)(Ki + row * 136 + lcc * 8) = pk[i];
      gas[row * 16 + lcc] = f2bf(pga[i]);
    }
    *(u32x4*)(VsB + buf * 64 * 72 + vrow * 72 + vcc * 8) = pv;
  };
  float bc[16];
  auto gate1 = [&]() {
    const bf16x8 ga = ldfrag(gas + (It * 32 + r) * 16 + 8 * h);
    f32x16 S = MFMA32(ga, w2f, zero16());
    float gt[4];
#pragma unroll
    for (int g = 0; g < 4; ++g) {
      float run = 0.f;
#pragma unroll
      for (int j = 0; j < 4; ++j) {
        const float s2 = (S[4 * g + j] + b2v) * 1.4426950408889634f;
        const float ls2 = s2 < -28.f ? s2 : -__builtin_amdgcn_logf(1.f + __builtin_amdgcn_exp2f(-s2));
        run += ls2 * (1.f / 16.f);
        bc[4 * g + j] = run;
      }
      gt[g] = run;
    }
    float off = 0.f;
#pragma unroll
    for (int g = 0; g < 4; ++g) {
      const float go = __shfl_xor(gt[g], 32);
      const float mine = off + (h ? go : 0.f);
#pragma unroll
      for (int j = 0; j < 4; ++j) bc[4 * g + j] += mine;
      off += gt[g] + go;
    }
    if (h == 0) seg[It * 128 + dcol] = off;
  };
  auto gate2 = [&](int buf) {
    u16* Qd = QdB + buf * 64 * 136;
    u16* Ki = KiB + buf * 64 * 136;
    const float t0 = seg[dcol], t1 = seg[128 + dcol];
    if (It == 0 && h == 0) blastB[buf * 128 + dcol] = t0 + t1;
    const float base = It ? t0 : 0.f;
#pragma unroll
    for (int reg = 0; reg < 16; ++reg) {
      const int i = It * 32 + crow(reg, h);
      const float bb = bc[reg] + base;
      const float eb = __builtin_amdgcn_exp2f(bb), rb = __builtin_amdgcn_exp2f(-bb);
      const float qv = bf2f(Qd[i * 136 + dcol]), kv = bf2f(Ki[i * 136 + dcol]);
      Qd[i * 136 + dcol] = f2bf(qv * eb);
      Ki[i * 136 + dcol] = f2bf(kv * rb);
    }
  };
  f32x16 Z;
  auto out_mfma = [&](int buf) {
    const u16* Qd = QdB + buf * 64 * 136;
    const u16* Ki = KiB + buf * 64 * 136;
    const u16* Vs = VsB + buf * 64 * 72;
    Z = zero16();
    auto pair_acc = [&](int J) {
      {
        f32x16 X = zero16();
#pragma unroll
        for (int kk = 0; kk < 8; ++kk) {
          bf16x8 a = ldfrag(Ki + (J * 32 + r) * 136 + kk * 16 + 8 * h);
          bf16x8 bq = ldfrag(Qd + (I * 32 + r) * 136 + kk * 16 + 8 * h);
          X = MFMA32(a, bq, X);
        }
#pragma unroll
        for (int reg = 0; reg < 16; ++reg) {
          const bool keep = (J < I) || (crow(reg, h) <= r);
          X[reg] = keep ? X[reg] : 0.f;
        }
#pragma unroll
        for (int s = 0; s < 2; ++s) {
          bf16x8 xs = pack_step(X, s);
          bf16x8 pb = frag_tr(Vs, 72, J * 32 + 16 * s + 4 * h, J * 32 + 16 * s + 8 + 4 * h, dvt * 32, lane);
          Z = MFMA32(xs, pb, Z);
        }
      }
    };
    if (role == 0) {
      pair_acc(I);
    } else {
#pragma unroll
      for (int kk = 0; kk < 8; ++kk) {
        bf16x8 a = ldfrag(Qd + (I * 32 + r) * 136 + kk * 16 + 8 * h);
        bf16x8 bq = ldfrag(Ss + (dvt * 32 + r) * 136 + kk * 16 + 8 * h);
        Z = MFMA32(a, bq, Z);
      }
      if (I == 1) pair_acc(0);
#pragma unroll
      for (int reg = 0; reg < 16; ++reg) Op[(I * 32 + crow(reg, h)) * 65 + dvt * 32 + r] = Z[reg];
    }
  };

  gload(0);
  __syncthreads();
  fill(0);
  gload(1);
  __syncthreads();
  gate1();
  __syncthreads();
  gate2(0);
#pragma unroll 1
  for (int t = 0; t < 68; ++t) {
    const int cb = t & 1, nb = cb ^ 1;
    const bool has_next = t + 1 < 68;
    const int tb = chunk_base(t);
    __syncthreads();
    if (has_next) {
      fill(nb);
      if (t + 2 < 68) gload(t + 2);
    }
    __syncthreads();
    if (w < 4) {
      out_mfma(cb);
      if (has_next) gate1();
    } else {
      if (has_next) gate1();
      out_mfma(cb);
    }
    __syncthreads();
    if (has_next) gate2(nb);
    if (role == 0) {
#pragma unroll
      for (int reg = 0; reg < 16; ++reg) {
        const int i = I * 32 + crow(reg, h);
        const float val = Z[reg] + Op[i * 65 + dvt * 32 + r];
        const int tl = dir ? 63 - i : i;
        obuf[(size_t)(tb + tl) * 1536 + ocol + dvt * 32 + r] = f2bf(val);
      }
    }
    {
      const u16* Ki = KiB + cb * 64 * 136;
      const u16* Vs = VsB + cb * 64 * 72;
#pragma unroll
      for (int kk = 0; kk < 4; ++kk) {
        bf16x8 a = frag_tr(Ki, 136, kk * 16 + 8 * h, kk * 16 + 8 * h + 4, dtile * 32, lane);
        bf16x8 bq = frag_tr(Vs, 72, kk * 16 + 8 * h, kk * 16 + 8 * h + 4, dv2 * 32, lane);
        sacc = MFMA32(a, bq, sacc);
      }
#pragma unroll
      for (int reg = 0; reg < 16; ++reg) sacc[reg] *= __builtin_amdgcn_exp2f(blastB[cb * 128 + dtile * 32 + crow(reg, h)]);
#pragma unroll
      for (int gq = 0; gq < 4; ++gq) {
        u32x2 o = {pack2(sacc[4 * gq], sacc[4 * gq + 1]), pack2(sacc[4 * gq + 2], sacc[4 * gq + 3])};
        *(u32x2*)(Ss + (dv2 * 32 + r) * 136 + dtile * 32 + 8 * gq + 4 * h) = o;
      }
    }
  }
  __syncthreads();
}

DI void phase_gate(const Params& p, int l, int r0) {
  u16* yb = (u16*)(p.ws + OFF_B);
  const u16* zb = (const u16*)(p.ws + OFF_C);
  u16* ob = (u16*)(p.ws + OFF_E);
  const u16* ofa = (const u16*)(p.ws + OFF_A);
  const u16* ofb = (const u16*)(p.ws + OFF_B);
  const u16* rb = (const u16*)(p.ws + OFF_F);
  const float* sng = p.in[13] + l * 1024;
  const float* gng = p.in[16] + l * 256;
  const int tid = get_tid();
  const int lane = tid & 63;
  const int gw = blockIdx.x * (NT / 64) + (tid >> 6), nw = gridDim.x * (NT / 64);
  const float4 gg = *(const float4*)(gng + lane * 4);
  float4 sg[2][2];
#pragma unroll
  for (int grp = 0; grp < 2; ++grp) {
    sg[grp][0] = *(const float4*)(sng + grp * 512 + lane * 8);
    sg[grp][1] = *(const float4*)(sng + grp * 512 + lane * 8 + 4);
  }
  u32x4 nyv[2][2], nzv[2][2];
  u32x2 nov[2][4], nov2[2][4], nrv[2][4];
  auto tload = [&](int tok) {
#pragma unroll
    for (int q = 0; q < 2; ++q) {
#pragma unroll
      for (int grp = 0; grp < 2; ++grp) {
        nyv[q][grp] = *(const u32x4*)(yb + (size_t)(tok + q) * 1536 + grp * 512 + lane * 8);
        nzv[q][grp] = *(const u32x4*)(zb + (size_t)(tok + q) * 1024 + grp * 512 + lane * 8);
      }
#pragma unroll
      for (int hh = 0; hh < 4; ++hh) {
        nov[q][hh] = *(const u32x2*)(ofa + (size_t)(tok + q) * 1536 + hh * 256 + lane * 4);
        nov2[q][hh] = *(const u32x2*)((hh < 2 ? ofa : ofb) + (size_t)(tok + q) * 1536 + 1024 + (hh & 1) * 256 + lane * 4);
        nrv[q][hh] = *(const u32x2*)(rb + (size_t)(tok + q) * 1024 + hh * 256 + lane * 4);
      }
    }
  };
  if (r0 + 2 * gw < TT) tload(r0 + 2 * gw);
  for (int tok = r0 + 2 * gw; tok < TT; tok += 2 * nw) {
    u32x4 yv[2][2], zv[2][2];
    u32x2 ov[2][4], ov2[2][4], rv[2][4];
#pragma unroll
    for (int q = 0; q < 2; ++q) {
#pragma unroll
      for (int grp = 0; grp < 2; ++grp) { yv[q][grp] = nyv[q][grp]; zv[q][grp] = nzv[q][grp]; }
#pragma unroll
      for (int hh = 0; hh < 4; ++hh) { ov[q][hh] = nov[q][hh]; ov2[q][hh] = nov2[q][hh]; rv[q][hh] = nrv[q][hh]; }
    }
    if (tok + 2 * nw < TT) tload(tok + 2 * nw);
    float gv[2][2][8], ss[2][6];
#pragma unroll
    for (int q = 0; q < 2; ++q) {
#pragma unroll
      for (int grp = 0; grp < 2; ++grp) {
        float s = 0.f;
#pragma unroll
        for (int j = 0; j < 4; ++j) {
          const float a = bflo(yv[q][grp][j]) * siluf(bflo(zv[q][grp][j]));
          const float c = bfhi(yv[q][grp][j]) * siluf(bfhi(zv[q][grp][j]));
          gv[q][grp][2 * j] = a; gv[q][grp][2 * j + 1] = c;
          s += a * a + c * c;
        }
        ss[q][grp] = s;
      }
#pragma unroll
      for (int hh = 0; hh < 4; ++hh) {
        const float o0 = bflo(ov[q][hh][0]) + bflo(ov2[q][hh][0]), o1 = bfhi(ov[q][hh][0]) + bfhi(ov2[q][hh][0]);
        const float o2 = bflo(ov[q][hh][1]) + bflo(ov2[q][hh][1]), o3 = bfhi(ov[q][hh][1]) + bfhi(ov2[q][hh][1]);
        ss[q][2 + hh] = o0 * o0 + o1 * o1 + o2 * o2 + o3 * o3;
      }
    }
#pragma unroll
    for (int o = 32; o >= 1; o >>= 1)
#pragma unroll
      for (int q = 0; q < 2; ++q)
#pragma unroll
        for (int k = 0; k < 6; ++k) ss[q][k] += __shfl_xor(ss[q][k], o);
#pragma unroll
    for (int q = 0; q < 2; ++q) {
#pragma unroll
      for (int grp = 0; grp < 2; ++grp) {
        const float rstd = rsqrtf(ss[q][grp] * (1.f / 512.f) + EPS);
        const float4 g0 = sg[grp][0], g1 = sg[grp][1];
        u32x4 o;
        o[0] = pack2(gv[q][grp][0] * rstd * g0.x, gv[q][grp][1] * rstd * g0.y);
        o[1] = pack2(gv[q][grp][2] * rstd * g0.z, gv[q][grp][3] * rstd * g0.w);
        o[2] = pack2(gv[q][grp][4] * rstd * g1.x, gv[q][grp][5] * rstd * g1.y);
        o[3] = pack2(gv[q][grp][6] * rstd * g1.z, gv[q][grp][7] * rstd * g1.w);
        *(u32x4*)(yb + (size_t)(tok + q) * 1536 + grp * 512 + lane * 8) = o;
      }
#pragma unroll
      for (int hh = 0; hh < 4; ++hh) {
        const float rstd = rsqrtf(ss[q][2 + hh] * (1.f / 256.f) + EPS);
        const float o0 = bflo(ov[q][hh][0]) + bflo(ov2[q][hh][0]), o1 = bfhi(ov[q][hh][0]) + bfhi(ov2[q][hh][0]);
        const float o2 = bflo(ov[q][hh][1]) + bflo(ov2[q][hh][1]), o3 = bfhi(ov[q][hh][1]) + bfhi(ov2[q][hh][1]);
        u32x2 o;
        o[0] = pack2(o0 * rstd * gg.x * siluf(bflo(rv[q][hh][0])), o1 * rstd * gg.y * siluf(bfhi(rv[q][hh][0])));
        o[1] = pack2(o2 * rstd * gg.z * siluf(bflo(rv[q][hh][1])), o3 * rstd * gg.w * siluf(bfhi(rv[q][hh][1])));
        *(u32x2*)(ob + (size_t)(tok + q) * 1024 + hh * 256 + lane * 4) = o;
      }
    }
  }
}

__global__ void __launch_bounds__(NT) fwd_megakernel(Params p) {
  extern __shared__ __attribute__((aligned(16))) char smem[];
  __shared__ uint4 xb_words;
  cg::grid_group grid = cg::this_grid();
  unsigned char* ws = p.ws;
  unsigned* bar = (unsigned*)(ws + OFF_BAR);
  if (threadIdx.x == 0) xb_words = make_uint4(0u, 0u, 0u, 0u);
  if (blockIdx.x == 0)
    for (int i = threadIdx.x; i < XCD_BAR_WORDS; i += NT) bar[i] = 0u;
  __syncthreads();
#pragma unroll 1
  for (int step = 0; step < 22; ++step) {
    const int l = step == 0 ? 0 : (step - 1) / 10;
    const int ph = step == 0 ? -1 : (step == 21 ? 10 : (step - 1) % 10);
    const float* mods_l = (const float*)(ws + OFF_MODS) + (size_t)l * 9 * 6144;
    const int r0 = l == 0 ? 0 : TC;
    const int mt0 = l == 0 ? 0 : 8;
    switch (ph) {
      case -1:
        phase_adaln(p, smem);
        break;
      case 0: {
        convert_w(p.in[7] + (size_t)l * 1024 * INC, 1024, INC, (u16*)(ws + OFF_WIN), INP, 1, smem);
        if (l == 0)
          norm_mod<false, false>(p.in[2], p.in[0], nullptr, nullptr, nullptr, nullptr, 0, p.in[6], mods_l, 0, 1024,
                                 (u16*)(ws + OFF_B), 0);
        else
          norm_mod<true, false>((const float*)(ws + OFF_HCTX), p.out, (float*)(ws + OFF_HCTX), p.out,
                                (const u16*)(ws + OFF_A), (const float*)(ws + OFF_MODS) + (size_t)(l - 1) * 9 * 6144, 5120,
                                p.in[6] + l * 1024, mods_l, 0, 1024, (u16*)(ws + OFF_B), 0, (const u16*)(ws + OFF_SLAB));
      } break;
      case 1:
        gemm_stream_phase<EPI_IN>(p, l, (const u16*)(ws + OFF_B), 1024, (const u16*)(ws + OFF_B), 1024, 1 << 30,
                              (const u16*)(ws + OFF_WIN), 1024, 0, 136, 23, smem);
        break;
      case 2:
        phase_conv(p, l);
        break;
      case 3:
        for (int item = blockIdx.x; item < 256; item += gridDim.x) ssd_item(p, l, item, smem);
        break;
      case 4:
        for (int item = blockIdx.x; item < 256; item += gridDim.x) gla_item(p, l, item, smem);
        break;
      case 5:
        convert_w(p.in[17] + (size_t)l * 2048 * 1024, 2048, 1024, (u16*)(ws + OFF_WOUT), 1024, 0, smem);
        phase_gate(p, l, r0);
        break;
      case 6:
        gemm_stream_phase<EPI_DELTA>(p, l, (const u16*)(ws + OFF_B), 1536, (const u16*)(ws + OFF_E), 1024, 16,
                               (const u16*)(ws + OFF_WOUT), 2048, mt0, 136, 4, smem, l == 0 ? NSPLIT : 1,
                               (u16*)(ws + OFF_SLAB));
        break;
      case 7:
        convert_w(p.in[19] + (size_t)l * 1024 * 4096, 1024, 4096, (u16*)(ws + OFF_WFF1), 4096, 0, smem);
        convert_w(p.in[20] + (size_t)l * 4096 * 1024, 4096, 1024, (u16*)(ws + OFF_WFF2), 1024, 0, smem);
        norm_mod<true, false>(l == 0 ? p.in[2] : (const float*)(ws + OFF_HCTX), l == 0 ? p.in[0] : p.out,
                              (float*)(ws + OFF_HCTX), p.out, (const u16*)(ws + OFF_A), mods_l, 2048,
                              p.in[18] + l * 1024, mods_l, 3072, 4096, (u16*)(ws + OFF_B), r0,
                              l == 0 ? (const u16*)(ws + OFF_SLAB) : nullptr);
        break;
      case 8:
        gemm_stream_phase<EPI_FF1>(p, l, (const u16*)(ws + OFF_B), 1024, (const u16*)(ws + OFF_B), 1024, 1 << 30,
                               (const u16*)(ws + OFF_WFF1), 1024, mt0, 136, 16, smem);
        break;
      case 9:
        gemm_stream_phase<EPI_DELTA>(p, l, (const u16*)(ws + OFF_C), 4096, (const u16*)(ws + OFF_C), 4096, 1 << 30,
                               (const u16*)(ws + OFF_WFF2), 4096, mt0, 136, 4, smem, l == 0 ? NSPLIT : 1,
                               (u16*)(ws + OFF_SLAB));
        break;
      default:
        norm_mod<true, true>((const float*)(ws + OFF_HCTX), p.out, (float*)(ws + OFF_HCTX), p.out,
                             (const u16*)(ws + OFF_A), (const float*)(ws + OFF_MODS) + (size_t)9 * 6144, 5120,
                             p.in[21], mods_l, 0, 1024, (u16*)(ws + OFF_B), TC);
        break;
    }
    if (step == 0) {
      grid.sync();
      (void)xcd_barrier_post((unsigned*)(p.ws + OFF_BAR), (volatile LAS unsigned*)&xb_words);
    } else if (step < 21) {
      XcdBarrier xb;
      xb.bar = (unsigned*)(p.ws + OFF_BAR); xb.x = xb_xcc_id(); xb.st = (volatile LAS unsigned*)&xb_words;
      xcd_barrier(xb);
    }
  }
}

extern "C" void kernel_launch(void* const* d_in, const int* in_sizes, int n_in, void* d_out, int out_size,
                              void* d_ws, size_t ws_size, hipStream_t stream) {
  static int grid_blocks = 0;
  if (!grid_blocks) {
    int dev = 0, cus = 0, per_cu = 0;
    (void)hipGetDevice(&dev);
    (void)hipDeviceGetAttribute(&cus, hipDeviceAttributeMultiprocessorCount, dev);
    (void)hipFuncSetAttribute((const void*)fwd_megakernel, hipFuncAttributeMaxDynamicSharedMemorySize, LDS_BYTES);
    (void)hipOccupancyMaxActiveBlocksPerMultiprocessor(&per_cu, fwd_megakernel, NT, LDS_BYTES);
    if (per_cu < 1) per_cu = 1;
    if (per_cu > 1) per_cu = 1;
    if (cus < 1) cus = 256;
    grid_blocks = cus * per_cu;
    if (ws_size < OFF_END) fprintf(stderr, "workspace too small: %zu < %zu\n", ws_size, (size_t)OFF_END);
  }
  Params p{};
  for (int i = 0; i < 22 && i < n_in; ++i) p.in[i] = (const float*)d_in[i];
  p.out = (float*)d_out;
  p.ws = (unsigned char*)d_ws;
  void* args[] = {&p};
  hipError_t e = hipLaunchCooperativeKernel((void*)fwd_megakernel, dim3(grid_blocks), dim3(NT), args, LDS_BYTES, stream);
  if (e != hipSuccess) fprintf(stderr, "cooperative launch failed: %s (grid %d)\n", hipGetErrorString(e), grid_blocks);
}
```

```cpp
#include <hip/hip_runtime.h>
#include <hip/hip_cooperative_groups.h>
#include <cstdio>
namespace cg = cooperative_groups;

typedef unsigned short u16;
typedef short bf16x8 __attribute__((ext_vector_type(8)));
typedef short s16x4 __attribute__((ext_vector_type(4)));
typedef float f32x16 __attribute__((ext_vector_type(16)));
typedef __bf16 bf16x2_t __attribute__((ext_vector_type(2)));
typedef float f32x2_t __attribute__((ext_vector_type(2)));
typedef unsigned u32x4 __attribute__((ext_vector_type(4)));
typedef unsigned u32x2 __attribute__((ext_vector_type(2)));

#define DI __device__ __forceinline__
#define NT 512
#define LDS_BYTES 131072
#define MFMA32(a, b, c) __builtin_amdgcn_mfma_f32_32x32x16_bf16((a), (b), (c), 0, 0, 0)

constexpr int TC = 2048;
constexpr int TL = 32768;
constexpr int TT = TC + TL;
constexpr int INC = 5696;
constexpr int INP = 5888;
constexpr float EPS = 1e-6f;

constexpr size_t SZ_A = (size_t)TT * 1536 * 2;
constexpr size_t SZ_1K = (size_t)TT * 1024 * 2;
constexpr size_t OFF_A = 0;
constexpr size_t OFF_B = OFF_A + SZ_A;
constexpr size_t OFF_C = OFF_B + SZ_A;
constexpr size_t OFF_D = OFF_C + SZ_1K;
constexpr size_t OFF_E = OFF_D + SZ_1K;
constexpr size_t OFF_F = OFF_E + SZ_1K;
constexpr size_t SZ_G = (size_t)TT * 32 * 4;
constexpr size_t OFF_DT = OFF_F + SZ_1K;
constexpr size_t OFF_GA = OFF_DT + SZ_G;
constexpr size_t OFF_HCTX = OFF_GA + SZ_G;
constexpr size_t OFF_MODS = OFF_HCTX + (size_t)TC * 1024 * 4;
constexpr size_t OFF_END = OFF_MODS + (size_t)2 * 9 * 6144 * 4;
constexpr size_t OFF_WIN = OFF_B + SZ_1K;
constexpr size_t OFF_BAR = OFF_END + (size_t)4 * 1024 * 1024;
constexpr size_t OFF_WOUT = OFF_END;
constexpr size_t OFF_WFF1 = OFF_BAR + (size_t)16 * 1024;
constexpr size_t OFF_WFF2 = OFF_A + (size_t)92 * 1024 * 1024;
constexpr size_t OFF_SLAB = OFF_A + (size_t)68 * 1024 * 1024;
constexpr int NSPLIT = 4;
constexpr int TEMP_ELEMS = 4352 * 32;

struct Params {
  const float* in[22];
  float* out;
  unsigned char* ws;
};

DI unsigned pack2(float a, float b) {
  f32x2_t v = {a, b};
  bf16x2_t r = __builtin_convertvector(v, bf16x2_t);
  return __builtin_bit_cast(unsigned, r);
}
DI u16 f2bf(float a) { return (u16)(pack2(a, 0.f) & 0xffffu); }
DI float bf2f(u16 v) { return __uint_as_float(((unsigned)v) << 16); }
DI float bflo(unsigned v) { return __uint_as_float(v << 16); }
DI float bfhi(unsigned v) { return __uint_as_float(v & 0xffff0000u); }
DI float wave_sum(float v) {
#pragma unroll
  for (int o = 32; o >= 1; o >>= 1) v += __shfl_xor(v, o);
  return v;
}
DI float siluf(float x) { return x * __builtin_amdgcn_rcpf(1.f + __builtin_amdgcn_exp2f(-1.4426950408889634f * x)); }
DI int get_tid() { int t = threadIdx.x; asm volatile("" : "+v"(t)); return t; }
DI int crow(int reg, int h) { return (reg & 3) + 8 * (reg >> 2) + 4 * h; }
DI bf16x8 ldfrag(const u16* p) { return *(const bf16x8*)p; }
DI s16x4 tr4(const u16* p) {
  return __builtin_amdgcn_ds_read_tr16_b64_v4i16((__attribute__((address_space(3))) s16x4*)p);
}
DI bf16x8 frag_tr(const u16* img, int ld, int k_lo, int k_hi, int c0, int lane) {
  const int i16 = lane & 15, q = i16 >> 2, pp = i16 & 3, blk = (lane >> 4) & 1;
  s16x4 lo = tr4(img + (k_lo + q) * ld + c0 + 16 * blk + 4 * pp);
  s16x4 hi = tr4(img + (k_hi + q) * ld + c0 + 16 * blk + 4 * pp);
  return __builtin_shufflevector(lo, hi, 0, 1, 2, 3, 4, 5, 6, 7);
}
DI bf16x8 pack_step(const f32x16& x, int s) {
  u32x4 p;
  p[0] = pack2(x[8 * s + 0], x[8 * s + 1]);
  p[1] = pack2(x[8 * s + 2], x[8 * s + 3]);
  p[2] = pack2(x[8 * s + 4], x[8 * s + 5]);
  p[3] = pack2(x[8 * s + 6], x[8 * s + 7]);
  return __builtin_bit_cast(bf16x8, p);
}
DI f32x16 zero16() {
  f32x16 z;
#pragma unroll
  for (int i = 0; i < 16; ++i) z[i] = 0.f;
  return z;
}

#define XB_TMO      128
#define XB_XCNT(j)  (256  + 64 * (j))
#define XB_XSUB(j)  (1280 + 64 * (j))
#define XB_XGEN(j)  (2304 + 64 * (j))
#define XB_TOP      3328
#define XB_TOPGEN   3392
#define XCD_BAR_WORDS 3456
#define XB_SPIN_CAP (1u << 18)
#define LAS __attribute__((address_space(3)))

__device__ __forceinline__ unsigned xb_ld(unsigned* p)              { return __hip_atomic_load(p, __ATOMIC_RELAXED, __HIP_MEMORY_SCOPE_AGENT); }
__device__ __forceinline__ unsigned xb_add(unsigned* p, unsigned v) { return __hip_atomic_fetch_add(p, v, __ATOMIC_RELAXED, __HIP_MEMORY_SCOPE_AGENT); }
__device__ __forceinline__ unsigned xb_xcc_id() { return (unsigned)__builtin_amdgcn_s_getreg((3 << 11) | 20) & 0xFu; }
#define XB_SPIN(cond, bar) do { unsigned _sp = 0; while (cond) { __builtin_amdgcn_s_sleep(1); \
    if ((++_sp & 255u) == 0u) { if (xb_ld(&(bar)[XB_TMO])) break; if (_sp > XB_SPIN_CAP) { atomicAdd(&(bar)[XB_TMO], 1u); break; } } } } while (0)

struct XcdBarrier {
    unsigned* bar; unsigned x;
    volatile LAS unsigned* st;
};

__device__ __forceinline__ XcdBarrier xcd_barrier_post(unsigned* bar, volatile LAS unsigned* st) {
    XcdBarrier b; b.bar = bar; b.x = xb_xcc_id(); b.st = st;
    if (threadIdx.x == 0) (void)xb_add(&bar[XB_XCNT(b.x)], 1u);
    return b;
}
__device__ __forceinline__ void xcd_barrier_complete(unsigned* bar, unsigned x, unsigned& nloc, unsigned& nx) {
    const unsigned G = gridDim.x * gridDim.y * gridDim.z;
    unsigned sum, cnt, mine, sp = 0u;
    for (;;) {
        sum = 0u; cnt = 0u; mine = 0u;
#pragma unroll
        for (unsigned j = 0; j < 16; ++j) { const unsigned c = xb_ld(&bar[XB_XCNT(j)]); sum += c; cnt += (c > 0u) ? 1u : 0u; mine = (j == x) ? c : mine; }
        if (sum == G) break;
        __builtin_amdgcn_s_sleep(1);
        if ((++sp & 255u) == 0u) { if (xb_ld(&bar[XB_TMO])) break; if (sp > XB_SPIN_CAP) { atomicAdd(&bar[XB_TMO], 1u); break; } }
    }
    nloc = mine > 0u ? mine : 1u; nx = cnt > 0u ? cnt : 1u;
}

__device__ __forceinline__ void xcd_barrier(const XcdBarrier& b) {
    asm volatile("s_waitcnt vmcnt(0)" ::: "memory");
    __syncthreads();
    if (threadIdx.x == 0) {
        unsigned* bar = b.bar;
        __builtin_amdgcn_s_waitcnt(0);
        unsigned nloc = b.st[0], nx = b.st[1];
        if (nloc == 0u) { xcd_barrier_complete(bar, b.x, nloc, nx); b.st[0] = nloc; b.st[1] = nx; }
        const unsigned old = xb_add(&bar[XB_XSUB(b.x)], 1u);
        const unsigned gen = old / nloc;
        if (old + 1u == (gen + 1u) * nloc) {
            __builtin_amdgcn_fence(__ATOMIC_RELEASE, "agent");
            asm volatile("s_waitcnt vmcnt(0)" ::: "memory");
            const unsigned og = xb_add(&bar[XB_TOP], 1u);
            const unsigned tg = og / nx;
            if (og + 1u == (tg + 1u) * nx) xb_add(&bar[XB_TOPGEN], 1u);
            else XB_SPIN(xb_ld(&bar[XB_TOPGEN]) == tg, bar);
            __builtin_amdgcn_fence(__ATOMIC_ACQUIRE, "agent");
            xb_add(&bar[XB_XGEN(b.x)], 1u);
            asm volatile("s_waitcnt vmcnt(0)" ::: "memory");
        } else {
            XB_SPIN(xb_ld(&bar[XB_XGEN(b.x)]) == gen, bar);
            __builtin_amdgcn_fence(__ATOMIC_ACQUIRE, "agent");
            asm volatile("s_waitcnt vmcnt(0)" ::: "memory");
        }
    }
    __syncthreads();
}

DI void phase_adaln(const Params& p, char* smem) {
  const int tid = get_tid();
  float* sc = (float*)smem;
  float* red = sc + 9 * 1024;
  const float* c = p.in[1];
  const float* cctx = p.in[3];
  const float* w_ada = p.in[4];
  const float* b_ada = p.in[5];
  float* mods = (float*)(p.ws + OFF_MODS);
  for (int i = tid; i < 9 * 1024; i += NT) {
    int j = i >> 10, k = i & 1023;
    float v = j < 8 ? c[j * 1024 + k] : cctx[k];
    sc[i] = siluf(v);
  }
  __syncthreads();
  for (int item = blockIdx.x; item < 192; item += gridDim.x) {
    const int l = item / 96, n0 = (item % 96) * 64;
    const int kg = tid >> 6, nn = tid & 63;
    float acc[9];
#pragma unroll
    for (int j = 0; j < 9; ++j) acc[j] = 0.f;
    const float* w = w_ada + (size_t)l * 1024 * 6144 + n0 + nn;
#pragma unroll 1
    for (int k = kg * 128; k < kg * 128 + 128; k += 32) {
      float wv[32];
#pragma unroll
      for (int q = 0; q < 32; ++q) wv[q] = w[(size_t)(k + q) * 6144];
#pragma unroll
      for (int j = 0; j < 9; ++j) {
#pragma unroll
        for (int q4 = 0; q4 < 8; ++q4) {
          const float4 s0 = *(const float4*)(sc + j * 1024 + k + 4 * q4);
          acc[j] += s0.x * wv[4 * q4] + s0.y * wv[4 * q4 + 1] + s0.z * wv[4 * q4 + 2] + s0.w * wv[4 * q4 + 3];
        }
      }
    }
#pragma unroll
    for (int j = 0; j < 9; ++j) red[(kg * 64 + nn) * 9 + j] = acc[j];
    __syncthreads();
    for (int t2 = tid; t2 < 576; t2 += NT) {
      int j = t2 >> 6, n2 = t2 & 63;
      float s = b_ada[l * 6144 + n0 + n2];
#pragma unroll
      for (int g = 0; g < 8; ++g) s += red[(g * 64 + n2) * 9 + j];
      mods[((size_t)l * 9 + j) * 6144 + n0 + n2] = s;
    }
    __syncthreads();
  }
}

DI int srccol(int mode, int n) {
  if (mode == 0) return n;
  if (n < 2560) return n;
  if (n < 5632) return n + 32;
  if (n < 5664) return n - 3072;
  if (n < 5696) return n;
  return -1;
}
DI void convert_w(const float* src, int K, int Nsrc, u16* dst, int Npad, int mode, char* smem) {
  float* Tt = (float*)smem;
  const int tid = get_tid();
  const int kts = K >> 6;
  const int ntiles = kts * (Npad >> 6);
  const int lr = tid >> 4, lc = (tid & 15) * 4;
  float4 pre[2];
  auto tload = [&](int tile) {
    const int kt = tile % kts, nt = tile / kts;
    const int scn = srccol(mode, nt * 64 + lc);
#pragma unroll
    for (int i = 0; i < 2; ++i)
      pre[i] = scn >= 0 ? *(const float4*)(src + (size_t)(kt * 64 + lr + 32 * i) * Nsrc + scn) : make_float4(0.f, 0.f, 0.f, 0.f);
  };
  int tile = blockIdx.x;
  if (tile < ntiles) tload(tile);
  for (; tile < ntiles; tile += gridDim.x) {
    const int kt = tile % kts, nt = tile / kts;
#pragma unroll
    for (int i = 0; i < 2; ++i) *(float4*)(Tt + (lr + 32 * i) * 68 + lc) = pre[i];
    if (tile + (int)gridDim.x < ntiles) tload(tile + gridDim.x);
    __syncthreads();
    {
      int nn = tid >> 3, kc = tid & 7;
      u32x4 o;
#pragma unroll
      for (int j = 0; j < 4; ++j)
        o[j] = pack2(Tt[(kc * 8 + 2 * j) * 68 + nn], Tt[(kc * 8 + 2 * j + 1) * 68 + nn]);
      *(u32x4*)(dst + (size_t)(nt * 64 + nn) * K + kt * 64 + kc * 8) = o;
    }
    __syncthreads();
  }
}

template <bool HAS_DELTA, bool FINAL>
DI void norm_mod(const float* hc_src, const float* hl_src, float* hc_dst, float* hl_dst, const u16* delta,
                 const float* gate_mods, int gate_off, const float* g, const float* mods_l, int shoff, int scoff,
                 u16* u, int r0, const u16* slabs = nullptr) {
  const int tid = get_tid();
  const int lane = tid & 63;
  const int gw = blockIdx.x * (NT / 64) + (tid >> 6), nw = gridDim.x * (NT / 64);
  float4 nv[2][4];
  u32x2 ndv[2][4];
  auto rload = [&](int r) {
    const float* src = r < TC ? hc_src + (size_t)r * 1024 : hl_src + (size_t)(r - TC) * 1024;
#pragma unroll
    for (int q = 0; q < 2; ++q)
#pragma unroll
      for (int i = 0; i < 4; ++i) {
        const int col = i * 256 + lane * 4;
        {
          typedef float f32x4nt __attribute__((ext_vector_type(4)));
          const f32x4nt t4 = __builtin_nontemporal_load((const f32x4nt*)(src + q * 1024 + col));
          nv[q][i] = make_float4(t4[0], t4[1], t4[2], t4[3]);
        }
        if (HAS_DELTA) {
          if (slabs != nullptr && r < TC) {
            float s0 = 0.f, s1 = 0.f, s2 = 0.f, s3 = 0.f;
#pragma unroll
            for (int sl = 0; sl < NSPLIT; ++sl) {
              const u32x2 t = *(const u32x2*)(slabs + (size_t)sl * TC * 1024 + (size_t)(r + q) * 1024 + col);
              s0 += bflo(t[0]); s1 += bfhi(t[0]); s2 += bflo(t[1]); s3 += bfhi(t[1]);
            }
            u32x2 pk = {pack2(s0, s1), pack2(s2, s3)};
            ndv[q][i] = pk;
          } else {
            ndv[q][i] = __builtin_nontemporal_load((const u32x2*)(delta + (size_t)(r + q) * 1024 + col));
          }
        }
      }
  };
  int r = r0 + 2 * gw;
  if (r < TT) rload(r);
  for (; r < TT; r += 2 * nw) {
    const bool isctx = r < TC;
    const int j = isctx ? 8 : (r - TC) >> 12;
    const float* md = mods_l + j * 6144;
    float4 v[2][4], g4[4], sh[4], sc[4], gt[4];
    u32x2 dv[2][4];
#pragma unroll
    for (int q = 0; q < 2; ++q)
#pragma unroll
      for (int i = 0; i < 4; ++i) { v[q][i] = nv[q][i]; if (HAS_DELTA) dv[q][i] = ndv[q][i]; }
#pragma unroll
    for (int i = 0; i < 4; ++i) {
      const int col = i * 256 + lane * 4;
      g4[i] = *(const float4*)(g + col);
      if (HAS_DELTA) gt[i] = *(const float4*)(gate_mods + j * 6144 + gate_off + col);
      if (!FINAL) {
        sh[i] = *(const float4*)(md + shoff + col);
        sc[i] = *(const float4*)(md + scoff + col);
      }
    }
    if (r + 2 * nw < TT) rload(r + 2 * nw);
    float ss[2] = {0.f, 0.f};
#pragma unroll
    for (int q = 0; q < 2; ++q)
#pragma unroll
      for (int i = 0; i < 4; ++i) {
        const int col = i * 256 + lane * 4;
        if (HAS_DELTA) {
          v[q][i].x += gt[i].x * bflo(dv[q][i][0]); v[q][i].y += gt[i].y * bfhi(dv[q][i][0]);
          v[q][i].z += gt[i].z * bflo(dv[q][i][1]); v[q][i].w += gt[i].w * bfhi(dv[q][i][1]);
          if (!FINAL) {
            float* dst = isctx ? hc_dst + (size_t)(r + q) * 1024 : hl_dst + (size_t)(r + q - TC) * 1024;
            *(float4*)(dst + col) = v[q][i];
          }
        }
        ss[q] += v[q][i].x * v[q][i].x + v[q][i].y * v[q][i].y + v[q][i].z * v[q][i].z + v[q][i].w * v[q][i].w;
      }
#pragma unroll
    for (int o = 32; o >= 1; o >>= 1) { ss[0] += __shfl_xor(ss[0], o); ss[1] += __shfl_xor(ss[1], o); }
#pragma unroll
    for (int q = 0; q < 2; ++q) {
      const float rstd = rsqrtf(ss[q] * (1.f / 1024.f) + EPS);
#pragma unroll
      for (int i = 0; i < 4; ++i) {
        const int col = i * 256 + lane * 4;
        if (FINAL) {
          float4 o = {v[q][i].x * rstd * g4[i].x, v[q][i].y * rstd * g4[i].y, v[q][i].z * rstd * g4[i].z, v[q][i].w * rstd * g4[i].w};
          *(float4*)(hl_dst + (size_t)(r + q - TC) * 1024 + col) = o;
        } else {
          float a0 = v[q][i].x * rstd * g4[i].x * (1.f + sc[i].x) + sh[i].x;
          float a1 = v[q][i].y * rstd * g4[i].y * (1.f + sc[i].y) + sh[i].y;
          float a2 = v[q][i].z * rstd * g4[i].z * (1.f + sc[i].z) + sh[i].z;
          float a3 = v[q][i].w * rstd * g4[i].w * (1.f + sc[i].w) + sh[i].w;
          u32x2 o = {pack2(a0, a1), pack2(a2, a3)};
          *(u32x2*)(u + (size_t)(r + q) * 1024 + col) = o;
        }
      }
    }
  }
}

enum { EPI_IN = 0, EPI_DELTA = 1, EPI_FF1 = 2 };

constexpr int G_HT = 128 * 64;
DI int g_lds_byte(int r, int c) {
  int st = (r >> 4) * 2 + (c >> 5), rr = r & 15, cc = c & 31, ob = rr * 64 + cc * 2;
  return st * 1024 + (ob ^ (((ob >> 9) & 1) << 5));
}
DI void g_stage_rc(int b, int& R, int& C) {
  int st = b / 1024, sb = b % 1024, swz = sb ^ (((sb >> 9) & 1) << 5);
  R = (st >> 1) * 16 + swz / 64;
  C = (st & 1) * 32 + (swz % 64) / 2;
}
typedef float f32x4v __attribute__((ext_vector_type(4)));

template <int EPI>
DI void gemm256_phase(const Params& p, int l, const u16* A0, int lda0, const u16* A1, int lda1, int ksplit_kt,
                      const u16* Bt, int K, int mt0, int mt1, int nN, char* smem, int nsplit = 1, u16* slabs = nullptr) {
  u16* shm = (u16*)smem;
  const int tid = get_tid();
  const int wid = tid >> 6, lane = tid & 63, wr = wid >> 2, wc = wid & 3, fr = lane & 15, fq = lane >> 4;
  const int nctx = nsplit > 1 ? 8 * nN * nsplit : 0;
  const int mlat0 = nsplit > 1 ? 8 : mt0;
  const int nM = mt1 - mlat0, nwg = nM * nN, nt = K >> 6, nunits = nctx + nwg;
  int sr0, sc0;
  g_stage_rc(tid * 16, sr0, sc0);
  const unsigned voffB = (unsigned)(sr0 * K + sc0) * 2u;
  const int laneoff = (fr * 64 + fq * 16) ^ ((fr >> 3) << 5);
  const char* aBase = (const char*)shm + wr * 8192 + laneoff;
  const char* bBase = (const char*)shm + 65536 + wc * 4096 + laneoff;
#define G_SA(b, h) (shm + ((b) * 2 + (h)) * G_HT)
#define G_SB(b, h) (shm + (4 + (b) * 2 + (h)) * G_HT)
#define G_STAGE_B(P, br, kt) do { const char* _g = (const char*)Bt + ((size_t)(br) * K + (size_t)((kt) + kbase) * 64) * 2; \
    __builtin_amdgcn_global_load_lds((const unsigned*)(_g + voffB), (unsigned*)((char*)(P) + tid * 16), 16, 0, 0); \
    __builtin_amdgcn_global_load_lds((const unsigned*)(_g + (size_t)K * 128 + voffB), (unsigned*)((char*)(P) + tid * 16 + 8192), 16, 0, 0); } while (0)
#define G_STAGE_A(P, br, kt) do { const u16* _b; int _ld, _kk; const int _kt = (kt) + kbase; \
    if (_kt < ksplit_kt) { _b = A0; _ld = lda0; _kk = _kt; } else { _b = A1; _ld = lda1; _kk = _kt - ksplit_kt; } \
    const char* _g = (const char*)_b + ((size_t)(br) * _ld + (size_t)_kk * 64) * 2; \
    const unsigned _vo = (unsigned)(sr0 * _ld + sc0) * 2u; \
    __builtin_amdgcn_global_load_lds((const unsigned*)(_g + _vo), (unsigned*)((char*)(P) + tid * 16), 16, 0, 0); \
    __builtin_amdgcn_global_load_lds((const unsigned*)(_g + (size_t)_ld * 128 + _vo), (unsigned*)((char*)(P) + tid * 16 + 8192), 16, 0, 0); } while (0)
#define G_LDA(dst, b, h) _Pragma("unroll") for (int m = 0; m < 4; ++m) _Pragma("unroll") for (int k = 0; k < 2; ++k) \
    dst[m][k] = *reinterpret_cast<const bf16x8*>(aBase + ((b) * 2 + (h)) * 16384 + (m * 2 + k) * 1024)
#define G_LDB(dst, b, h) _Pragma("unroll") for (int n = 0; n < 2; ++n) _Pragma("unroll") for (int k = 0; k < 2; ++k) \
    dst[n][k] = *reinterpret_cast<const bf16x8*>(bBase + ((b) * 2 + (h)) * 16384 + (n * 2 + k) * 1024)
#define G_MMA(ai, bj, At_, Bt_) do { __builtin_amdgcn_s_setprio(1); \
    _Pragma("unroll") for (int m = 0; m < 4; ++m) _Pragma("unroll") for (int n = 0; n < 2; ++n) _Pragma("unroll") for (int k = 0; k < 2; ++k) \
      acc[ai][bj][m][n] = __builtin_amdgcn_mfma_f32_16x16x32_bf16(Bt_[n][k], At_[m][k], acc[ai][bj][m][n], 0, 0, 0); \
    __builtin_amdgcn_s_setprio(0); } while (0)
#define G_WAIT_V(n) asm volatile("s_waitcnt vmcnt(" #n ")" ::: "memory")
#define G_WAIT_L(n) asm volatile("s_waitcnt lgkmcnt(" #n ")" ::: "memory")
#define G_BAR __builtin_amdgcn_s_barrier()
#define G_SCHED __builtin_amdgcn_sched_barrier(0)
  auto tile_rc = [&](int unit_, int& brow_, int& bcol_, int& kbase_, int& ntl_, int& dsel_) {
    if (unit_ < nctx) {
      const int ks = unit_ % nsplit, t_ = unit_ / nsplit;
      brow_ = (t_ & 7) * 256; bcol_ = (t_ >> 3) * 256;
      ntl_ = nt / nsplit; kbase_ = ks * ntl_; dsel_ = ks + 1;
      return;
    }
    kbase_ = 0; ntl_ = nt; dsel_ = 0;
    int wgid = unit_ - nctx;
    { int q = nwg / 8, rq = nwg % 8, xcd = wgid % 8, off = wgid / 8;
      wgid = (xcd < rq ? xcd * (q + 1) : rq * (q + 1) + (xcd - rq) * q) + off; }
    const int nig = 8 * nN, gid = wgid / nig, fm = gid * 8, gsz = min(nM - fm, 8);
    const int pm = fm + ((wgid % nig) % gsz), pn = (wgid % nig) / gsz;
    brow_ = (mlat0 + pm) * 256; bcol_ = pn * 256;
  };
  bool pre = false;
  for (int tile = blockIdx.x; tile < nunits; tile += gridDim.x) {
    int brow, bcol, kbase, ntl, dsel;
    tile_rc(tile, brow, bcol, kbase, ntl, dsel);
    f32x4v acc[2][2][4][2];
#pragma unroll
    for (int a = 0; a < 2; ++a)
#pragma unroll
      for (int b2 = 0; b2 < 2; ++b2)
#pragma unroll
        for (int m = 0; m < 4; ++m)
#pragma unroll
          for (int n = 0; n < 2; ++n) { f32x4v z = {0.f, 0.f, 0.f, 0.f}; acc[a][b2][m][n] = z; }
    bf16x8 At[4][2], B0[2][2], B1[2][2];
    if (!pre) {
      G_STAGE_B(G_SB(0, 0), bcol, 0); G_STAGE_A(G_SA(0, 0), brow, 0);
      G_STAGE_B(G_SB(0, 1), bcol + 128, 0); G_STAGE_A(G_SA(0, 1), brow + 128, 0);
    }
    if (wr == 1) G_BAR;
    G_WAIT_V(4); G_BAR;
    G_STAGE_B(G_SB(1, 0), bcol, 1); G_STAGE_A(G_SA(1, 0), brow, 1); G_STAGE_B(G_SB(1, 1), bcol + 128, 1);
    G_WAIT_V(6); G_BAR;
    for (int t = 0; t < ntl - 2; t += 2) {
      G_LDB(B0, 0, 0); G_SCHED; G_LDA(At, 0, 0); G_STAGE_A(G_SA(1, 1), brow + 128, t + 1);
      G_WAIT_L(8); G_BAR; G_WAIT_L(0); G_MMA(0, 0, At, B0); G_BAR; G_SCHED;
      G_LDB(B1, 0, 1); G_STAGE_B(G_SB(0, 0), bcol, t + 2);
      G_BAR; G_WAIT_L(0); G_MMA(0, 1, At, B1); G_BAR;
      G_LDA(At, 0, 1); G_STAGE_A(G_SA(0, 0), brow, t + 2);
      G_BAR; G_WAIT_L(0); G_MMA(1, 0, At, B0); G_BAR; G_SCHED;
      G_STAGE_B(G_SB(0, 1), bcol + 128, t + 2);
      G_WAIT_V(6); G_BAR; G_MMA(1, 1, At, B1); G_BAR;
      G_LDB(B0, 1, 0); G_SCHED; G_LDA(At, 1, 0); G_STAGE_A(G_SA(0, 1), brow + 128, t + 2);
      G_WAIT_L(8); G_BAR; G_WAIT_L(0); G_MMA(0, 0, At, B0); G_BAR; G_SCHED;
      G_LDB(B1, 1, 1); G_STAGE_B(G_SB(1, 0), bcol, t + 3);
      G_BAR; G_WAIT_L(0); G_MMA(0, 1, At, B1); G_BAR;
      G_LDA(At, 1, 1); G_STAGE_A(G_SA(1, 0), brow, t + 3);
      G_BAR; G_WAIT_L(0); G_MMA(1, 0, At, B0); G_BAR; G_SCHED;
      G_STAGE_B(G_SB(1, 1), bcol + 128, t + 3);
      G_WAIT_V(6); G_BAR; G_MMA(1, 1, At, B1); G_BAR;
    }
    { G_LDB(B0, 0, 0); G_LDA(At, 0, 0); G_STAGE_A(G_SA(1, 1), brow + 128, ntl - 1);
      G_BAR; G_WAIT_L(0); G_MMA(0, 0, At, B0); G_BAR;
      G_LDB(B1, 0, 1); G_BAR; G_WAIT_L(0); G_MMA(0, 1, At, B1); G_BAR;
      G_LDA(At, 0, 1); G_WAIT_V(4); G_BAR; G_WAIT_L(0); G_MMA(1, 0, At, B0); G_MMA(1, 1, At, B1); G_BAR; }
    { G_LDB(B0, 1, 0); G_LDA(At, 1, 0); G_WAIT_V(2); G_BAR; G_WAIT_L(0); G_MMA(0, 0, At, B0); G_BAR;
      G_LDB(B1, 1, 1); G_WAIT_V(0); G_BAR; G_WAIT_L(0); G_MMA(0, 1, At, B1); G_BAR;
      G_LDA(At, 1, 1); G_BAR; G_WAIT_L(0); G_MMA(1, 0, At, B0); G_MMA(1, 1, At, B1); G_BAR; }
    if (wr == 0) G_BAR;
    G_SCHED;
    {
      const int tid2 = get_tid();
      const int wid2 = tid2 >> 6, lane2 = tid2 & 63;
      const int rbase = brow + (wid2 >> 2) * 64 + (lane2 & 15);
      const int cbase = bcol + (wid2 & 3) * 32 + (lane2 >> 4) * 4;
      unsigned char* ws = p.ws;
      const bool staged = !(EPI == EPI_IN && bcol == 5632);
      if (staged) {
        __syncthreads();
        typedef __attribute__((address_space(3))) char lds_char;
        lds_char* area0 = (lds_char*)((char*)shm + 32768);
        lds_char* area1 = (lds_char*)((char*)shm + 98304);
        const int wr2 = wid2 >> 2, wc2 = wid2 & 3, fr2 = lane2 & 15, fq2 = lane2 >> 4;
        const int wbase = (wr2 * 64 + fr2) * 256 + (((wc2 * 4 + (fq2 >> 1)) ^ fr2) << 4) + (fq2 & 1) * 8;
        const int rrow0 = tid2 >> 4, rG = tid2 & 15;
        const int rbase0 = rrow0 * 256 + ((rG ^ (rrow0 & 15)) << 4);
        u16* qdst[2]; int qld[2], qc0[2]; float qscale[2];
#pragma unroll
        for (int bj = 0; bj < 2; ++bj) {
          qscale[bj] = 1.f;
          if (EPI == EPI_IN) {
            const int nt128 = (bcol >> 7) + bj;
            int coff;
            if (nt128 < 8) { qdst[bj] = (u16*)(ws + OFF_C); qld[bj] = 1024; coff = 0; }
            else if (nt128 < 20) { qdst[bj] = (u16*)(ws + OFF_A); qld[bj] = 1536; coff = 1024; }
            else if (nt128 < 28) { qdst[bj] = (u16*)(ws + OFF_D); qld[bj] = 1024; coff = 2560; qscale[bj] = nt128 < 24 ? 0.08838834764831845f : 1.f; }
            else if (nt128 < 36) { qdst[bj] = (u16*)(ws + OFF_E); qld[bj] = 1024; coff = 3584; }
            else { qdst[bj] = (u16*)(ws + OFF_F); qld[bj] = 1024; coff = 4608; }
            qc0[bj] = bcol + bj * 128 - coff;
          } else if (EPI == EPI_FF1) {
            qdst[bj] = (u16*)(ws + OFF_C); qld[bj] = 4096; qc0[bj] = bcol + bj * 128;
          } else {
            qdst[bj] = dsel == 0 ? (u16*)(ws + OFF_A) : slabs + (size_t)(dsel - 1) * TC * 1024;
            qld[bj] = 1024; qc0[bj] = bcol + bj * 128;
          }
        }
#pragma unroll
        for (int ai = 0; ai < 2; ++ai) {
#pragma unroll
          for (int bj = 0; bj < 2; ++bj)
#pragma unroll
            for (int m = 0; m < 4; ++m)
#pragma unroll
              for (int n = 0; n < 2; ++n) {
                const f32x4v v = acc[ai][bj][m][n];
                u32x2 o;
                if (EPI == EPI_FF1) {
                  float r0 = fmaxf(v[0], 0.f), r1 = fmaxf(v[1], 0.f), r2 = fmaxf(v[2], 0.f), r3 = fmaxf(v[3], 0.f);
                  o[0] = pack2(r0 * r0, r1 * r1); o[1] = pack2(r2 * r2, r3 * r3);
                } else {
                  const float sc = qscale[bj];
                  o[0] = pack2(v[0] * sc, v[1] * sc); o[1] = pack2(v[2] * sc, v[3] * sc);
                }
                *(__attribute__((address_space(3))) u32x2*)((bj ? area1 : area0) + ((wbase ^ (n << 5)) + m * 4096)) = o;
              }
          __syncthreads();
#pragma unroll
          for (int bj = 0; bj < 2; ++bj)
#pragma unroll
            for (int i = 0; i < 4; ++i) {
              const u32x4 val = *(const __attribute__((address_space(3))) u32x4*)((bj ? area1 : area0) + rbase0 + i * 8192);
              *(u32x4*)((char*)qdst[bj] + (unsigned)((brow + ai * 128 + rrow0 + 32 * i) * qld[bj] + qc0[bj] + rG * 8) * 2u) = val;
            }
          __syncthreads();
        }
      } else if (EPI == EPI_IN) {
#pragma unroll
        for (int bj = 0; bj < 2; ++bj) {
          const int nt128 = (bcol >> 7) + bj;
          if (nt128 < 44) {
            u16* dst; int ld, coff; float scale = 1.f;
            if (nt128 < 8) { dst = (u16*)(ws + OFF_C); ld = 1024; coff = 0; }
            else if (nt128 < 20) { dst = (u16*)(ws + OFF_A); ld = 1536; coff = 1024; }
            else if (nt128 < 28) { dst = (u16*)(ws + OFF_D); ld = 1024; coff = 2560; scale = nt128 < 24 ? 0.08838834764831845f : 1.f; }
            else if (nt128 < 36) { dst = (u16*)(ws + OFF_E); ld = 1024; coff = 3584; }
            else { dst = (u16*)(ws + OFF_F); ld = 1024; coff = 4608; }
#pragma unroll
            for (int ai = 0; ai < 2; ++ai)
#pragma unroll
              for (int m = 0; m < 4; ++m)
#pragma unroll
                for (int n = 0; n < 2; ++n) {
                  const int row = rbase + ai * 128 + m * 16, col = cbase + bj * 128 + n * 16 - coff;
                  const f32x4v v = acc[ai][bj][m][n];
                  u32x2 o = {pack2(v[0] * scale, v[1] * scale), pack2(v[2] * scale, v[3] * scale)};
                  *(u32x2*)((char*)dst + (unsigned)(row * ld + col) * 2u) = o;
                }
          } else if (nt128 == 44) {
            float* dtp = (float*)(ws + OFF_DT);
            float* gap = (float*)(ws + OFF_GA);
            const float* dtb = p.in[10] + l * 32;
#pragma unroll
            for (int ai = 0; ai < 2; ++ai)
#pragma unroll
              for (int m = 0; m < 4; ++m)
#pragma unroll
                for (int n = 0; n < 2; ++n) {
                  const int row = rbase + ai * 128 + m * 16, c0 = cbase + bj * 128 + n * 16 - 5632;
                  const f32x4v v = acc[ai][bj][m][n];
                  if (c0 < 32) {
                    float4 o;
                    float x0 = v[0] + dtb[c0], x1 = v[1] + dtb[c0 + 1], x2 = v[2] + dtb[c0 + 2], x3 = v[3] + dtb[c0 + 3];
                    o.x = x0 > 20.f ? x0 : __logf(1.f + __expf(x0));
                    o.y = x1 > 20.f ? x1 : __logf(1.f + __expf(x1));
                    o.z = x2 > 20.f ? x2 : __logf(1.f + __expf(x2));
                    o.w = x3 > 20.f ? x3 : __logf(1.f + __expf(x3));
                    *(float4*)(dtp + (size_t)row * 32 + c0) = o;
                  } else if (c0 < 64) {
                    float4 o = {v[0], v[1], v[2], v[3]};
                    *(float4*)(gap + (size_t)row * 32 + (c0 - 32)) = o;
                  }
                }
          }
        }
      } else if (EPI == EPI_FF1) {
        u16* dst = (u16*)(ws + OFF_C);
#pragma unroll
        for (int ai = 0; ai < 2; ++ai)
#pragma unroll
          for (int bj = 0; bj < 2; ++bj)
#pragma unroll
            for (int m = 0; m < 4; ++m)
#pragma unroll
              for (int n = 0; n < 2; ++n) {
                const int row = rbase + ai * 128 + m * 16, col = cbase + bj * 128 + n * 16;
                const f32x4v v = acc[ai][bj][m][n];
                float r0 = fmaxf(v[0], 0.f), r1 = fmaxf(v[1], 0.f), r2 = fmaxf(v[2], 0.f), r3 = fmaxf(v[3], 0.f);
                u32x2 o = {pack2(r0 * r0, r1 * r1), pack2(r2 * r2, r3 * r3)};
                *(u32x2*)((char*)dst + (unsigned)(row * 4096 + col) * 2u) = o;
              }
      } else {
        u16* dst = dsel == 0 ? (u16*)(ws + OFF_A) : slabs + (size_t)(dsel - 1) * TC * 1024;
#pragma unroll
        for (int ai = 0; ai < 2; ++ai)
#pragma unroll
          for (int bj = 0; bj < 2; ++bj)
#pragma unroll
            for (int m = 0; m < 4; ++m)
#pragma unroll
              for (int n = 0; n < 2; ++n) {
                const int row = rbase + ai * 128 + m * 16, col = cbase + bj * 128 + n * 16;
                const f32x4v v = acc[ai][bj][m][n];
                u32x2 o = {pack2(v[0], v[1]), pack2(v[2], v[3])};
                *(u32x2*)((char*)dst + (unsigned)(row * 1024 + col) * 2u) = o;
              }
      }
    }
    G_WAIT_V(0);
    G_BAR;
  }
}

DI int g_perm32(int rho) { const int n = rho >> 4, i = rho & 15; return 8 * (i >> 2) + 4 * n + (i & 3); }

template <int EPI>
DI void gemm_stream_phase(const Params& p, int l, const u16* A0, int lda0, const u16* A1, int lda1, int ksplit_kt,
                          const u16* Bt, int K, int mt0, int mt1, int nN, char* smem, int nsplit = 1, u16* slabs = nullptr) {
  u16* shm = (u16*)smem;
  const int tid = get_tid();
  const int wid = tid >> 6, lane = tid & 63, wr = wid >> 2, wc = wid & 3, fr = lane & 15, fq = lane >> 4;
  const int nctx = nsplit > 1 ? 8 * nN * nsplit : 0;
  const int mlat0 = nsplit > 1 ? 8 : mt0;
  const int nM = mt1 - mlat0, nwg = nM * nN, nt = K >> 6, nunits = nctx + nwg;
  int sr0, sc0;
  g_stage_rc(tid * 16, sr0, sc0);
  const int srb = (sr0 & ~31) + g_perm32(sr0 & 31);
  const unsigned voffB = (unsigned)(srb * K + sc0) * 2u;
  const int laneoff = (fr * 64 + fq * 16) ^ ((fr >> 3) << 5);
  const char* aBase = (const char*)shm + wr * 8192 + laneoff;
  const char* bBase = (const char*)shm + 65536 + wc * 4096 + laneoff;
#define S_SA(b, h) (shm + ((b) * 2 + (h)) * G_HT)
#define S_SB(b, h) (shm + (4 + (b) * 2 + (h)) * G_HT)
#define S_STAGE_B(P, brw, ktabs) do { const char* _g = (const char*)Bt + ((size_t)(brw) * K + (size_t)(ktabs) * 64) * 2; \
    __builtin_amdgcn_global_load_lds((const unsigned*)(_g + voffB), (unsigned*)((char*)(P) + tid * 16), 16, 0, 0); \
    __builtin_amdgcn_global_load_lds((const unsigned*)(_g + (size_t)K * 128 + voffB), (unsigned*)((char*)(P) + tid * 16 + 8192), 16, 0, 0); } while (0)
#define S_STAGE_A(P, brw, ktabs) do { const u16* _b; int _ld, _kk; const int _kt = (ktabs); \
    if (_kt < ksplit_kt) { _b = A0; _ld = lda0; _kk = _kt; } else { _b = A1; _ld = lda1; _kk = _kt - ksplit_kt; } \
    const char* _g = (const char*)_b + ((size_t)(brw) * _ld + (size_t)_kk * 64) * 2; \
    const unsigned _vo = (unsigned)(sr0 * _ld + sc0) * 2u; \
    __builtin_amdgcn_global_load_lds((const unsigned*)(_g + _vo), (unsigned*)((char*)(P) + tid * 16), 16, 0, 0); \
    __builtin_amdgcn_global_load_lds((const unsigned*)(_g + (size_t)_ld * 128 + _vo), (unsigned*)((char*)(P) + tid * 16 + 8192), 16, 0, 0); } while (0)
#define S_LDA(dst, b, h) _Pragma("unroll") for (int m = 0; m < 4; ++m) _Pragma("unroll") for (int k = 0; k < 2; ++k) \
    dst[m][k] = *reinterpret_cast<const bf16x8*>(aBase + ((b) * 2 + (h)) * 16384 + (m * 2 + k) * 1024)
#define S_LDB(dst, b, h) _Pragma("unroll") for (int n = 0; n < 2; ++n) _Pragma("unroll") for (int k = 0; k < 2; ++k) \
    dst[n][k] = *reinterpret_cast<const bf16x8*>(bBase + ((b) * 2 + (h)) * 16384 + (n * 2 + k) * 1024)
#define S_MMA(ai, bj, At_, Bt_) do { __builtin_amdgcn_s_setprio(1); \
    _Pragma("unroll") for (int m = 0; m < 4; ++m) _Pragma("unroll") for (int n = 0; n < 2; ++n) _Pragma("unroll") for (int k = 0; k < 2; ++k) \
      acc[ai][bj][m][n] = __builtin_amdgcn_mfma_f32_16x16x32_bf16(Bt_[n][k], At_[m][k], acc[ai][bj][m][n], 0, 0, 0); \
    __builtin_amdgcn_s_setprio(0); } while (0)
  auto unit_rc = [&](int unit_, int& brow_, int& bcol_, int& kbase_, int& ntl_, int& dsel_) {
    if (unit_ < nctx) {
      const int ks = unit_ % nsplit, t_ = unit_ / nsplit;
      brow_ = (t_ & 7) * 256; bcol_ = (t_ >> 3) * 256;
      ntl_ = nt / nsplit; kbase_ = ks * ntl_; dsel_ = ks + 1;
      return;
    }
    kbase_ = 0; ntl_ = nt; dsel_ = 0;
    int wgid = unit_ - nctx;
    { int q = nwg / 8, rq = nwg % 8, xcd = wgid % 8, off = wgid / 8;
      wgid = (xcd < rq ? xcd * (q + 1) : rq * (q + 1) + (xcd - rq) * q) + off; }
    const int nig = 8 * nN, gid = wgid / nig, fm = gid * 8, gsz = min(nM - fm, 8);
    const int pm = fm + ((wgid % nig) % gsz), pn = (wgid % nig) / gsz;
    brow_ = (mlat0 + pm) * 256; bcol_ = pn * 256;
  };
  int unit = blockIdx.x;
  if (unit >= nunits) return;
  int brow, bcol, kbase, ntl, dsel;
  unit_rc(unit, brow, bcol, kbase, ntl, dsel);
  f32x4v acc[2][2][4][2];
#pragma unroll
  for (int a = 0; a < 2; ++a)
#pragma unroll
    for (int b2 = 0; b2 < 2; ++b2)
#pragma unroll
      for (int m = 0; m < 4; ++m)
#pragma unroll
        for (int n = 0; n < 2; ++n) { f32x4v z = {0.f, 0.f, 0.f, 0.f}; acc[a][b2][m][n] = z; }
  bf16x8 At[4][2], B0[2][2], B1[2][2];
  S_STAGE_B(S_SB(0, 0), bcol, kbase); S_STAGE_A(S_SA(0, 0), brow, kbase);
  S_STAGE_B(S_SB(0, 1), bcol + 128, kbase); S_STAGE_A(S_SA(0, 1), brow + 128, kbase);
  if (wr == 1) G_BAR;
  G_WAIT_V(4); G_BAR;
  S_STAGE_B(S_SB(1, 0), bcol, kbase + 1); S_STAGE_A(S_SA(1, 0), brow, kbase + 1); S_STAGE_B(S_SB(1, 1), bcol + 128, kbase + 1);
  G_WAIT_V(6); G_BAR;
  for (;;) {
    const bool has_next = unit + (int)gridDim.x < nunits;
    int nbrow = brow, nbcol = bcol, nkb = kbase, nntl = ntl, ndsel = dsel;
    if (has_next) unit_rc(unit + gridDim.x, nbrow, nbcol, nkb, nntl, ndsel);
#pragma unroll 1
    for (int t = 0; t < ntl; t += 2) {
      const bool last = (t == ntl - 2);
      const int r2 = last ? nbrow : brow, c2 = last ? nbcol : bcol;
      const int k1 = kbase + t + 1, k2 = last ? nkb : kbase + t + 2, k3 = k2 + 1;
      G_LDB(B0, 0, 0); G_SCHED; G_LDA(At, 0, 0); S_STAGE_A(S_SA(1, 1), brow + 128, k1);
      G_WAIT_L(8); G_BAR; G_WAIT_L(0); S_MMA(0, 0, At, B0); G_BAR; G_SCHED;
      G_LDB(B1, 0, 1); S_STAGE_B(S_SB(0, 0), c2, k2);
      G_BAR; G_WAIT_L(0); S_MMA(0, 1, At, B1); G_BAR;
      G_LDA(At, 0, 1); S_STAGE_A(S_SA(0, 0), r2, k2);
      G_BAR; G_WAIT_L(0); S_MMA(1, 0, At, B0); G_BAR; G_SCHED;
      S_STAGE_B(S_SB(0, 1), c2 + 128, k2);
      G_WAIT_V(6); G_BAR; S_MMA(1, 1, At, B1); G_BAR;
      G_LDB(B0, 1, 0); G_SCHED; G_LDA(At, 1, 0); S_STAGE_A(S_SA(0, 1), r2 + 128, k2);
      G_WAIT_L(8); G_BAR; G_WAIT_L(0); S_MMA(0, 0, At, B0); G_BAR; G_SCHED;
      G_LDB(B1, 1, 1); S_STAGE_B(S_SB(1, 0), c2, k3);
      G_BAR; G_WAIT_L(0); S_MMA(0, 1, At, B1); G_BAR;
      G_LDA(At, 1, 1); S_STAGE_A(S_SA(1, 0), r2, k3);
      G_BAR; G_WAIT_L(0); S_MMA(1, 0, At, B0); G_BAR; G_SCHED;
      S_STAGE_B(S_SB(1, 1), c2 + 128, k3);
      G_WAIT_V(6); G_BAR; S_MMA(1, 1, At, B1); G_BAR;
    }
    G_SCHED;
    {
      const int tid2 = get_tid();
      const int wid2 = tid2 >> 6, lane2 = tid2 & 63;
      const int rbase = brow + (wid2 >> 2) * 64 + (lane2 & 15);
      const int cbase = bcol + (wid2 & 3) * 32 + (lane2 >> 4) * 8;
      unsigned char* ws = p.ws;
      if (EPI == EPI_IN && bcol == 5632) {
        const int c0 = cbase - 5632;
        float* dtp = (float*)(ws + OFF_DT);
        float* gap = (float*)(ws + OFF_GA);
        const float* dtb = p.in[10] + l * 32;
        if (c0 < 64) {
#pragma unroll
          for (int ai = 0; ai < 2; ++ai)
#pragma unroll
            for (int m = 0; m < 4; ++m) {
              const int row = rbase + ai * 128 + m * 16;
#pragma unroll
              for (int n = 0; n < 2; ++n) {
                const f32x4v v = acc[ai][0][m][n];
                const int cc = c0 + 4 * n;
                if (c0 < 32) {
                  float4 o;
                  float x0 = v[0] + dtb[cc], x1 = v[1] + dtb[cc + 1], x2 = v[2] + dtb[cc + 2], x3 = v[3] + dtb[cc + 3];
                  o.x = x0 > 20.f ? x0 : __logf(1.f + __expf(x0));
                  o.y = x1 > 20.f ? x1 : __logf(1.f + __expf(x1));
                  o.z = x2 > 20.f ? x2 : __logf(1.f + __expf(x2));
                  o.w = x3 > 20.f ? x3 : __logf(1.f + __expf(x3));
                  *(float4*)(dtp + (size_t)row * 32 + cc) = o;
                } else {
                  float4 o = {v[0], v[1], v[2], v[3]};
                  *(float4*)(gap + (size_t)row * 32 + (cc - 32)) = o;
                }
              }
            }
        }
      } else {
        u16* qdst[2]; int qld[2], qc0[2]; float qscale[2];
#pragma unroll
        for (int bj = 0; bj < 2; ++bj) {
          qscale[bj] = 1.f;
          if (EPI == EPI_IN) {
            const int nt128 = (bcol >> 7) + bj;
            int coff;
            if (nt128 < 8) { qdst[bj] = (u16*)(ws + OFF_C); qld[bj] = 1024; coff = 0; }
            else if (nt128 < 20) { qdst[bj] = (u16*)(ws + OFF_A); qld[bj] = 1536; coff = 1024; }
            else if (nt128 < 28) { qdst[bj] = (u16*)(ws + OFF_D); qld[bj] = 1024; coff = 2560; qscale[bj] = nt128 < 24 ? 0.08838834764831845f : 1.f; }
            else if (nt128 < 36) { qdst[bj] = (u16*)(ws + OFF_E); qld[bj] = 1024; coff = 3584; }
            else { qdst[bj] = (u16*)(ws + OFF_F); qld[bj] = 1024; coff = 4608; }
            qc0[bj] = cbase + bj * 128 - coff;
          } else if (EPI == EPI_FF1) {
            qdst[bj] = (u16*)(ws + OFF_C); qld[bj] = 4096; qc0[bj] = cbase + bj * 128;
          } else {
            qdst[bj] = dsel == 0 ? (u16*)(ws + OFF_A) : slabs + (size_t)(dsel - 1) * TC * 1024;
            qld[bj] = 1024; qc0[bj] = cbase + bj * 128;
          }
        }
#pragma unroll
        for (int ai = 0; ai < 2; ++ai)
#pragma unroll
          for (int m = 0; m < 4; ++m) {
            const int row = rbase + ai * 128 + m * 16;
#pragma unroll
            for (int bj = 0; bj < 2; ++bj) {
              const f32x4v v0 = acc[ai][bj][m][0], v1 = acc[ai][bj][m][1];
              u32x4 o;
              if (EPI == EPI_FF1) {
                float r0 = fmaxf(v0[0], 0.f), r1 = fmaxf(v0[1], 0.f), r2 = fmaxf(v0[2], 0.f), r3 = fmaxf(v0[3], 0.f);
                float r4 = fmaxf(v1[0], 0.f), r5 = fmaxf(v1[1], 0.f), r6 = fmaxf(v1[2], 0.f), r7 = fmaxf(v1[3], 0.f);
                o[0] = pack2(r0 * r0, r1 * r1); o[1] = pack2(r2 * r2, r3 * r3);
                o[2] = pack2(r4 * r4, r5 * r5); o[3] = pack2(r6 * r6, r7 * r7);
              } else {
                const float sc = qscale[bj];
                o[0] = pack2(v0[0] * sc, v0[1] * sc); o[1] = pack2(v0[2] * sc, v0[3] * sc);
                o[2] = pack2(v1[0] * sc, v1[1] * sc); o[3] = pack2(v1[2] * sc, v1[3] * sc);
              }
              *(u32x4*)((char*)qdst[bj] + (unsigned)(row * qld[bj] + qc0[bj]) * 2u) = o;
            }
          }
      }
    }
    G_SCHED;
    if (!has_next) break;
#pragma unroll
    for (int a = 0; a < 2; ++a)
#pragma unroll
      for (int b2 = 0; b2 < 2; ++b2)
#pragma unroll
        for (int m = 0; m < 4; ++m)
#pragma unroll
          for (int n = 0; n < 2; ++n) { f32x4v z = {0.f, 0.f, 0.f, 0.f}; acc[a][b2][m][n] = z; }
    unit += gridDim.x; brow = nbrow; bcol = nbcol; kbase = nkb; ntl = nntl; dsel = ndsel;
  }
  G_WAIT_V(0);
  if (wr == 0) G_BAR;
  G_BAR;
#undef S_SA
#undef S_SB
#undef S_STAGE_A
#undef S_STAGE_B
#undef S_LDA
#undef S_LDB
#undef S_MMA
}

DI void phase_conv(const Params& p, int l) {
  const u16* pre = (const u16*)(p.ws + OFF_A);
  u16* post = (u16*)(p.ws + OFF_B);
  const float* cw = p.in[8] + (size_t)l * 9 * 1536;
  const float* cb = p.in[9] + (size_t)l * 1536;
  const int total = (TT / 8) * 192;
  for (int id = blockIdx.x * NT + get_tid(); id < total; id += gridDim.x * NT) {
    const int cg8 = id % 192, run = id / 192, tok0 = run * 8, ch = cg8 * 8;
    int W, H, row, col0, base;
    if (tok0 < TC) { W = 256; H = 1; row = 0; col0 = tok0 & 255; base = tok0 & ~255; }
    else { int t = tok0 - TC; int rem = t & 4095; row = rem >> 6; col0 = rem & 63; W = 64; H = 64; base = TC + (t & ~4095); }
    float wgt[9][8];
#pragma unroll
    for (int t9 = 0; t9 < 9; ++t9) {
      float4 a = *(const float4*)(cw + t9 * 1536 + ch), b = *(const float4*)(cw + t9 * 1536 + ch + 4);
      wgt[t9][0] = a.x; wgt[t9][1] = a.y; wgt[t9][2] = a.z; wgt[t9][3] = a.w;
      wgt[t9][4] = b.x; wgt[t9][5] = b.y; wgt[t9][6] = b.z; wgt[t9][7] = b.w;
    }
    float bias[8];
    { float4 a = *(const float4*)(cb + ch), b = *(const float4*)(cb + ch + 4);
      bias[0] = a.x; bias[1] = a.y; bias[2] = a.z; bias[3] = a.w; bias[4] = b.x; bias[5] = b.y; bias[6] = b.z; bias[7] = b.w; }
    bool rv[3];
    const u16* rp[3];
    float win[3][3][8];
    const u32x4 zz = {0u, 0u, 0u, 0u};
    auto unpack8 = [](const u32x4 v, float (&o)[8]) {
#pragma unroll
      for (int j = 0; j < 4; ++j) { o[2 * j] = bflo(v[j]); o[2 * j + 1] = bfhi(v[j]); }
    };
#pragma unroll
    for (int dy = 0; dy < 3; ++dy) {
      int rr = row + dy - 1;
      rv[dy] = (rr >= 0 && rr < H);
      rp[dy] = pre + (size_t)(base + rr * W) * 1536 + ch;
      unpack8((rv[dy] && col0 - 1 >= 0) ? *(const u32x4*)(rp[dy] + (size_t)(col0 - 1) * 1536) : zz, win[dy][0]);
      unpack8(rv[dy] ? *(const u32x4*)(rp[dy] + (size_t)col0 * 1536) : zz, win[dy][1]);
    }
#pragma unroll
    for (int t = 0; t < 8; ++t) {
      const int col = col0 + t;
      float acc[8];
#pragma unroll
      for (int j = 0; j < 8; ++j) acc[j] = bias[j];
#pragma unroll
      for (int dy = 0; dy < 3; ++dy) {
        unpack8((rv[dy] && col + 1 < W) ? *(const u32x4*)(rp[dy] + (size_t)(col + 1) * 1536) : zz, win[dy][2]);
#pragma unroll
        for (int dx = 0; dx < 3; ++dx) {
#pragma unroll
          for (int j = 0; j < 8; ++j) acc[j] += wgt[dy * 3 + dx][j] * win[dy][dx][j];
        }
#pragma unroll
        for (int j = 0; j < 8; ++j) { win[dy][0][j] = win[dy][1][j]; win[dy][1][j] = win[dy][2][j]; }
      }
      u32x4 o;
#pragma unroll
      for (int j = 0; j < 4; ++j) o[j] = pack2(siluf(acc[2 * j]), siluf(acc[2 * j + 1]));
      *(u32x4*)(post + (size_t)(tok0 + t) * 1536 + ch) = o;
    }
  }
}

DI void ssd_item(const Params& p, int l, int item, char* smem) {
  const int tid = get_tid(), lane = tid & 63, w = tid >> 6, r = lane & 31, h = lane >> 5;
  const int b = (item & 15) >> 1, g = item & 1, hd = g * 8 + (item >> 5), ph = (item >> 4) & 1;
  u16* Bs = (u16*)smem;
  u16* Cs = Bs + 128 * 136;
  u16* Xs = Cs + 128 * 136;
  u16* Xdt = Xs + 128 * 40;
  u16* Xd2 = Xdt + 128 * 40;
  u16* Hs = Xd2 + 128 * 40;
  float* av = (float*)(Hs + 2 * 32 * 136);
  float* dtv = av + 128;
  float* Pex = dtv + 128;
  u16* xb = (u16*)(p.ws + OFF_B);
  u16* temp = (u16*)(p.ws + OFF_A) + (size_t)item * TEMP_ELEMS;
  const float* dtg = (const float*)(p.ws + OFF_DT);
  const int xcol = hd * 64 + ph * 32;
  const int brow0 = tid >> 4, bcc = tid & 15;
  const int xrow = tid >> 2, xcc = tid & 3;

#pragma unroll 1
  for (int dir = 0; dir < 2; ++dir) {
    const float Aneg = -__expf(p.in[11][l * 32 + dir * 16 + hd]) * 1.4426950408889634f;
    const float Dk = p.in[12][l * 32 + dir * 16 + hd];
    f32x16 hacc = zero16();
    auto pair_acc = [&](int I, int J, f32x16& Z) {
      const float a_i = av[I * 32 + r];
      f32x16 X = zero16();
#pragma unroll
      for (int kk = 0; kk < 8; ++kk) {
        bf16x8 a = ldfrag(Bs + (J * 32 + r) * 136 + kk * 16 + 8 * h);
        bf16x8 bq = ldfrag(Cs + (I * 32 + r) * 136 + kk * 16 + 8 * h);
        X = MFMA32(a, bq, X);
      }
#pragma unroll
      for (int reg = 0; reg < 16; ++reg) {
        const int jl = crow(reg, h);
        const float aj = av[J * 32 + jl];
        const bool keep = (J < I) || (jl <= r);
        X[reg] = keep ? X[reg] * __builtin_amdgcn_exp2f(a_i - aj) : 0.f;
      }
#pragma unroll
      for (int s = 0; s < 2; ++s) {
        bf16x8 xs = pack_step(X, s);
        bf16x8 pb = frag_tr(Xdt, 40, J * 32 + 16 * s + 4 * h, J * 32 + 16 * s + 8 + 4 * h, 0, lane);
        Z = MFMA32(xs, pb, Z);
      }
    };
    __syncthreads();
    for (int i = tid; i < 2 * 32 * 136; i += NT) Hs[i] = 0;
    u32x4 pB[4], pC[4], pX;
    float pdt = 0.f;
    auto chunk_base = [&](int step, int& tb, int& ltb) {
      if (step < 2) { int c = dir ? 1 - step : step; tb = b * 256 + c * 128; ltb = c * 128; }
      else { int c = step - 2; if (dir) c = 31 - c; tb = TC + b * 4096 + c * 128; ltb = 256 + c * 128; }
    };
    auto gload = [&](int step) {
      int tb, ltb;
      chunk_base(step, tb, ltb);
#pragma unroll
      for (int i = 0; i < 4; ++i) {
        const int row = brow0 + 32 * i;
        const int tr = dir ? 127 - row : row;
        const u16* src = xb + (size_t)(tb + tr) * 1536 + 1024 + g * 128 + bcc * 8;
        pB[i] = *(const u32x4*)src;
        pC[i] = *(const u32x4*)(src + 256);
      }
      {
        const int tr = dir ? 127 - xrow : xrow;
        pX = *(const u32x4*)(xb + (size_t)(tb + tr) * 1536 + xcol + xcc * 8);
      }
      if (tid < 128) {
        const int tr = dir ? 127 - tid : tid;
        pdt = dtg[(size_t)(tb + tr) * 32 + dir * 16 + hd];
      }
    };
    gload(0);
#pragma unroll 1
    for (int step = 0; step < 34; ++step) {
      int tb, ltb;
      chunk_base(step, tb, ltb);
      const int cur = step & 1;
      __syncthreads();
#pragma unroll
      for (int i = 0; i < 4; ++i) {
        const int row = brow0 + 32 * i;
        *(u32x4*)(Bs + row * 136 + bcc * 8) = pB[i];
        *(u32x4*)(Cs + row * 136 + bcc * 8) = pC[i];
      }
      *(u32x4*)(Xs + xrow * 40 + xcc * 8) = pX;
      if (tid < 128) dtv[tid] = pdt;
      const u32x4 xv = pX;
      if (step + 1 < 34) gload(step + 1);
      __syncthreads();
      {
        float v0 = dtv[2 * lane] * Aneg, v1 = dtv[2 * lane + 1] * Aneg;
        float s = v0 + v1, incl = s;
#pragma unroll
        for (int o = 1; o < 64; o <<= 1) {
          float t = __shfl_up(incl, o);
          if (lane >= o) incl += t;
        }
        float excl = incl - s;
        av[2 * lane] = excl + v0;
        av[2 * lane + 1] = excl + s;
      }
      {
        const float dd = dtv[xrow];
        const float e = dd * __builtin_amdgcn_exp2f(av[127] - av[xrow]);
        u32x4 o1, o2;
#pragma unroll
        for (int j = 0; j < 4; ++j) {
          float x0 = bflo(xv[j]), x1 = bfhi(xv[j]);
          o1[j] = pack2(x0 * dd, x1 * dd);
          o2[j] = pack2(x0 * e, x1 * e);
        }
        *(u32x4*)(Xdt + xrow * 40 + xcc * 8) = o1;
        *(u32x4*)(Xd2 + xrow * 40 + xcc * 8) = o2;
      }
      __syncthreads();
      f32x16 Z = zero16();
      u16 tprev[16];
      const int I = 3 - (w & 3);
      if (w < 4) {
        const u16* Hc = Hs + cur * 32 * 136;
        if (dir == 1) {
#pragma unroll
          for (int reg = 0; reg < 16; ++reg) {
            const int il = I * 32 + crow(reg, h);
            tprev[reg] = temp[(size_t)(ltb + 127 - il) * 32 + r];
          }
        }
#pragma unroll
        for (int kk = 0; kk < 8; ++kk) {
          bf16x8 a = ldfrag(Cs + (I * 32 + r) * 136 + kk * 16 + 8 * h);
          bf16x8 bq = ldfrag(Hc + r * 136 + kk * 16 + 8 * h);
          Z = MFMA32(a, bq, Z);
        }
#pragma unroll
        for (int reg = 0; reg < 16; ++reg) Z[reg] *= __builtin_amdgcn_exp2f(av[I * 32 + crow(reg, h)]);
        const int Jlo = I == 3 ? 2 : (I == 2 ? 1 : 0);
#pragma unroll 1
        for (int J = Jlo; J <= I; ++J) pair_acc(I, J, Z);
      } else {
        const int nt = w - 4;
        u16* Hn = Hs + (cur ^ 1) * 32 * 136;
        const float dec = __builtin_amdgcn_exp2f(av[127]);
#pragma unroll
        for (int reg = 0; reg < 16; ++reg) hacc[reg] *= dec;
#pragma unroll
        for (int kk = 0; kk < 8; ++kk) {
          bf16x8 a = frag_tr(Bs, 136, kk * 16 + 8 * h, kk * 16 + 8 * h + 4, nt * 32, lane);
          bf16x8 bq = frag_tr(Xd2, 40, kk * 16 + 8 * h, kk * 16 + 8 * h + 4, 0, lane);
          hacc = MFMA32(a, bq, hacc);
        }
#pragma unroll
        for (int gq = 0; gq < 4; ++gq) {
          u32x2 o = {pack2(hacc[4 * gq], hacc[4 * gq + 1]), pack2(hacc[4 * gq + 2], hacc[4 * gq + 3])};
          *(u32x2*)(Hn + r * 136 + nt * 32 + 8 * gq + 4 * h) = o;
        }
        if (w < 6) {
          const int Ih = 7 - w;
#pragma unroll 1
          for (int J = 0; J < Ih - 1; ++J) pair_acc(Ih, J, Z);
          float* P = Pex + (w - 4) * 32 * 33;
#pragma unroll
          for (int reg = 0; reg < 16; ++reg) P[crow(reg, h) * 33 + r] = Z[reg];
        }
      }
      __syncthreads();
      if (w < 4) {
        const float* P = Pex + w * 32 * 33;
#pragma unroll
        for (int reg = 0; reg < 16; ++reg) {
          const int il = I * 32 + crow(reg, h);
          float yv = Z[reg] + Dk * bf2f(Xs[il * 40 + r]);
          if (w < 2) yv += P[crow(reg, h) * 33 + r];
          const int tl = dir ? 127 - il : il;
          if (dir == 0) {
            temp[(size_t)(ltb + tl) * 32 + r] = f2bf(yv);
          } else {
            yv += bf2f(tprev[reg]);
            xb[(size_t)(tb + tl) * 1536 + xcol + r] = f2bf(yv);
          }
        }
      }
    }
  }
  __syncthreads();
}

DI void gla_item(const Params& p, int l, int item, char* smem) {
  const int tid = get_tid(), lane = tid & 63, w = tid >> 6, r = lane & 31, h = lane >> 5;
  const int sl = item >> 6, b = (item & 63) >> 3, hd = (item >> 1) & 3, dir = item & 1;
  u16* QdB = (u16*)smem;
  u16* KiB = QdB + 2 * 64 * 136;
  u16* VsB = KiB + 2 * 64 * 136;
  u16* Ss = VsB + 2 * 64 * 72;
  u16* gas = Ss + 64 * 136;
  float* seg = (float*)(gas + 64 * 16);
  float* blastB = seg + 2 * 128;
  float* Op = blastB + 2 * 128;
  const u16* qk = (const u16*)(p.ws + OFF_D);
  const u16* vb = (const u16*)(p.ws + OFF_E);
  const float* gag = (const float*)(p.ws + OFF_GA);
  const int vcol = hd * 256 + sl * 64;
  u16* obuf = (u16*)(p.ws + ((dir == 1 && hd >= 2) ? OFF_B : OFF_A));
  const int ocol = dir == 0 ? vcol : 1024 + (vcol & 511);
  const int It = w >> 2, dtl = w & 3;
  const int dcol = dtl * 32 + r;
  const int lrow0 = tid >> 4, lcc = tid & 15;
  const int vrow = tid >> 3, vcc = tid & 7;
  const int I = w >> 2, dvt = (w >> 1) & 1, role = w & 1;
  const int dtile = w >> 1, dv2 = w & 1;

  bf16x8 w2f;
  {
    const float* w2p = p.in[14] + ((size_t)(l * 2 + dir) * 16 + 8 * h) * 512 + hd * 128 + dcol;
    u32x4 t;
#pragma unroll
    for (int j = 0; j < 4; ++j) t[j] = pack2(w2p[(2 * j) * 512], w2p[(2 * j + 1) * 512]);
    w2f = __builtin_bit_cast(bf16x8, t);
  }
  const float b2v = p.in[15][(l * 2 + dir) * 512 + hd * 128 + dcol];
  f32x16 sacc = zero16();
  __syncthreads();
  for (int i = tid; i < 64 * 136; i += NT) Ss[i] = 0;
  u32x4 pq[2], pk[2], pv;
  float pga[2];
  auto chunk_base = [&](int step) {
    int tb;
    if (step < 4) { int c = dir ? 3 - step : step; tb = b * 256 + c * 64; }
    else { int c = step - 4; if (dir) c = 63 - c; tb = TC + b * 4096 + c * 64; }
    return tb;
  };
  auto gload = [&](int step) {
    const int tb = chunk_base(step);
#pragma unroll
    for (int i = 0; i < 2; ++i) {
      const int row = lrow0 + 32 * i;
      const int tr = dir ? 63 - row : row;
      const u16* src = qk + (size_t)(tb + tr) * 1024 + hd * 128 + lcc * 8;
      pq[i] = *(const u32x4*)src;
      pk[i] = *(const u32x4*)(src + 512);
      pga[i] = gag[(size_t)(tb + tr) * 32 + dir * 16 + lcc];
    }
    {
      const int tr = dir ? 63 - vrow : vrow;
      pv = *(const u32x4*)(vb + (size_t)(tb + tr) * 1024 + vcol + vcc * 8);
    }
  };
  auto fill = [&](int buf) {
    u16* Qd = QdB + buf * 64 * 136;
    u16* Ki = KiB + buf * 64 * 136;
#pragma unroll
    for (int i = 0; i < 2; ++i) {
      const int row = lrow0 + 32 * i;
      *(u32x4*)(Qd + row * 136 + lcc * 8) = pq[i];
      *(u32x4*)(Ki + row * 136 + lcc * 8) = pk[i];
      gas[row * 16 + lcc] = f2bf(pga[i]);
    }
    *(u32x4*)(VsB + buf * 64 * 72 + vrow * 72 + vcc * 8) = pv;
  };
  float bc[16];
  auto gate1 = [&]() {
    const bf16x8 ga = ldfrag(gas + (It * 32 + r) * 16 + 8 * h);
    f32x16 S = MFMA32(ga, w2f, zero16());
    float gt[4];
#pragma unroll
    for (int g = 0; g < 4; ++g) {
      float run = 0.f;
#pragma unroll
      for (int j = 0; j < 4; ++j) {
        const float s2 = (S[4 * g + j] + b2v) * 1.4426950408889634f;
        const float ls2 = s2 < -28.f ? s2 : -__builtin_amdgcn_logf(1.f + __builtin_amdgcn_exp2f(-s2));
        run += ls2 * (1.f / 16.f);
        bc[4 * g + j] = run;
      }
      gt[g] = run;
    }
    float off = 0.f;
#pragma unroll
    for (int g = 0; g < 4; ++g) {
      const float go = __shfl_xor(gt[g], 32);
      const float mine = off + (h ? go : 0.f);
#pragma unroll
      for (int j = 0; j < 4; ++j) bc[4 * g + j] += mine;
      off += gt[g] + go;
    }
    if (h == 0) seg[It * 128 + dcol] = off;
  };
  auto gate2 = [&](int buf) {
    u16* Qd = QdB + buf * 64 * 136;
    u16* Ki = KiB + buf * 64 * 136;
    const float t0 = seg[dcol], t1 = seg[128 + dcol];
    if (It == 0 && h == 0) blastB[buf * 128 + dcol] = t0 + t1;
    const float base = It ? t0 : 0.f;
#pragma unroll
    for (int reg = 0; reg < 16; ++reg) {
      const int i = It * 32 + crow(reg, h);
      const float bb = bc[reg] + base;
      const float eb = __builtin_amdgcn_exp2f(bb), rb = __builtin_amdgcn_exp2f(-bb);
      const float qv = bf2f(Qd[i * 136 + dcol]), kv = bf2f(Ki[i * 136 + dcol]);
      Qd[i * 136 + dcol] = f2bf(qv * eb);
      Ki[i * 136 + dcol] = f2bf(kv * rb);
    }
  };
  f32x16 Z;
  auto out_mfma = [&](int buf) {
    const u16* Qd = QdB + buf * 64 * 136;
    const u16* Ki = KiB + buf * 64 * 136;
    const u16* Vs = VsB + buf * 64 * 72;
    Z = zero16();
    if (role == 0) {
#pragma unroll 1
      for (int J = 0; J <= I; ++J) {
        f32x16 X = zero16();
#pragma unroll
        for (int kk = 0; kk < 8; ++kk) {
          bf16x8 a = ldfrag(Ki + (J * 32 + r) * 136 + kk * 16 + 8 * h);
          bf16x8 bq = ldfrag(Qd + (I * 32 + r) * 136 + kk * 16 + 8 * h);
          X = MFMA32(a, bq, X);
        }
#pragma unroll
        for (int reg = 0; reg < 16; ++reg) {
          const bool keep = (J < I) || (crow(reg, h) <= r);
          X[reg] = keep ? X[reg] : 0.f;
        }
#pragma unroll
        for (int s = 0; s < 2; ++s) {
          bf16x8 xs = pack_step(X, s);
          bf16x8 pb = frag_tr(Vs, 72, J * 32 + 16 * s + 4 * h, J * 32 + 16 * s + 8 + 4 * h, dvt * 32, lane);
          Z = MFMA32(xs, pb, Z);
        }
      }
    } else {
#pragma unroll
      for (int kk = 0; kk < 8; ++kk) {
        bf16x8 a = ldfrag(Qd + (I * 32 + r) * 136 + kk * 16 + 8 * h);
        bf16x8 bq = ldfrag(Ss + (dvt * 32 + r) * 136 + kk * 16 + 8 * h);
        Z = MFMA32(a, bq, Z);
      }
#pragma unroll
      for (int reg = 0; reg < 16; ++reg) Op[(I * 32 + crow(reg, h)) * 65 + dvt * 32 + r] = Z[reg];
    }
  };

  gload(0);
  __syncthreads();
  fill(0);
  gload(1);
  __syncthreads();
  gate1();
  __syncthreads();
  gate2(0);
#pragma unroll 1
  for (int t = 0; t < 68; ++t) {
    const int cb = t & 1, nb = cb ^ 1;
    const bool has_next = t + 1 < 68;
    const int tb = chunk_base(t);
    __syncthreads();
    if (has_next) {
      fill(nb);
      if (t + 2 < 68) gload(t + 2);
    }
    __syncthreads();
    if (w < 4) {
      out_mfma(cb);
      if (has_next) gate1();
    } else {
      if (has_next) gate1();
      out_mfma(cb);
    }
    __syncthreads();
    if (has_next) gate2(nb);
    if (role == 0) {
#pragma unroll
      for (int reg = 0; reg < 16; ++reg) {
        const int i = I * 32 + crow(reg, h);
        const float val = Z[reg] + Op[i * 65 + dvt * 32 + r];
        const int tl = dir ? 63 - i : i;
        obuf[(size_t)(tb + tl) * 1536 + ocol + dvt * 32 + r] = f2bf(val);
      }
    }
    {
      const u16* Ki = KiB + cb * 64 * 136;
      const u16* Vs = VsB + cb * 64 * 72;
#pragma unroll
      for (int kk = 0; kk < 4; ++kk) {
        bf16x8 a = frag_tr(Ki, 136, kk * 16 + 8 * h, kk * 16 + 8 * h + 4, dtile * 32, lane);
        bf16x8 bq = frag_tr(Vs, 72, kk * 16 + 8 * h, kk * 16 + 8 * h + 4, dv2 * 32, lane);
        sacc = MFMA32(a, bq, sacc);
      }
#pragma unroll
      for (int reg = 0; reg < 16; ++reg) sacc[reg] *= __builtin_amdgcn_exp2f(blastB[cb * 128 + dtile * 32 + crow(reg, h)]);
#pragma unroll
      for (int gq = 0; gq < 4; ++gq) {
        u32x2 o = {pack2(sacc[4 * gq], sacc[4 * gq + 1]), pack2(sacc[4 * gq + 2], sacc[4 * gq + 3])};
        *(u32x2*)(Ss + (dv2 * 32 + r) * 136 + dtile * 32 + 8 * gq + 4 * h) = o;
      }
    }
  }
  __syncthreads();
}

DI void phase_gate(const Params& p, int l, int r0) {
  u16* yb = (u16*)(p.ws + OFF_B);
  const u16* zb = (const u16*)(p.ws + OFF_C);
  u16* ob = (u16*)(p.ws + OFF_E);
  const u16* ofa = (const u16*)(p.ws + OFF_A);
  const u16* ofb = (const u16*)(p.ws + OFF_B);
  const u16* rb = (const u16*)(p.ws + OFF_F);
  const float* sng = p.in[13] + l * 1024;
  const float* gng = p.in[16] + l * 256;
  const int tid = get_tid();
  const int lane = tid & 63;
  const int gw = blockIdx.x * (NT / 64) + (tid >> 6), nw = gridDim.x * (NT / 64);
  const float4 gg = *(const float4*)(gng + lane * 4);
  float4 sg[2][2];
#pragma unroll
  for (int grp = 0; grp < 2; ++grp) {
    sg[grp][0] = *(const float4*)(sng + grp * 512 + lane * 8);
    sg[grp][1] = *(const float4*)(sng + grp * 512 + lane * 8 + 4);
  }
  u32x4 nyv[2][2], nzv[2][2];
  u32x2 nov[2][4], nov2[2][4], nrv[2][4];
  auto tload = [&](int tok) {
#pragma unroll
    for (int q = 0; q < 2; ++q) {
#pragma unroll
      for (int grp = 0; grp < 2; ++grp) {
        nyv[q][grp] = __builtin_nontemporal_load((const u32x4*)(yb + (size_t)(tok + q) * 1536 + grp * 512 + lane * 8));
        nzv[q][grp] = __builtin_nontemporal_load((const u32x4*)(zb + (size_t)(tok + q) * 1024 + grp * 512 + lane * 8));
      }
#pragma unroll
      for (int hh = 0; hh < 4; ++hh) {
        nov[q][hh] = __builtin_nontemporal_load((const u32x2*)(ofa + (size_t)(tok + q) * 1536 + hh * 256 + lane * 4));
        nov2[q][hh] = __builtin_nontemporal_load((const u32x2*)((hh < 2 ? ofa : ofb) + (size_t)(tok + q) * 1536 + 1024 + (hh & 1) * 256 + lane * 4));
        nrv[q][hh] = __builtin_nontemporal_load((const u32x2*)(rb + (size_t)(tok + q) * 1024 + hh * 256 + lane * 4));
      }
    }
  };
  if (r0 + 2 * gw < TT) tload(r0 + 2 * gw);
  for (int tok = r0 + 2 * gw; tok < TT; tok += 2 * nw) {
    u32x4 yv[2][2], zv[2][2];
    u32x2 ov[2][4], ov2[2][4], rv[2][4];
#pragma unroll
    for (int q = 0; q < 2; ++q) {
#pragma unroll
      for (int grp = 0; grp < 2; ++grp) { yv[q][grp] = nyv[q][grp]; zv[q][grp] = nzv[q][grp]; }
#pragma unroll
      for (int hh = 0; hh < 4; ++hh) { ov[q][hh] = nov[q][hh]; ov2[q][hh] = nov2[q][hh]; rv[q][hh] = nrv[q][hh]; }
    }
    if (tok + 2 * nw < TT) tload(tok + 2 * nw);
    float gv[2][2][8], ss[2][6];
#pragma unroll
    for (int q = 0; q < 2; ++q) {
#pragma unroll
      for (int grp = 0; grp < 2; ++grp) {
        float s = 0.f;
#pragma unroll
        for (int j = 0; j < 4; ++j) {
          const float a = bflo(yv[q][grp][j]) * siluf(bflo(zv[q][grp][j]));
          const float c = bfhi(yv[q][grp][j]) * siluf(bfhi(zv[q][grp][j]));
          gv[q][grp][2 * j] = a; gv[q][grp][2 * j + 1] = c;
          s += a * a + c * c;
        }
        ss[q][grp] = s;
      }
#pragma unroll
      for (int hh = 0; hh < 4; ++hh) {
        const float o0 = bflo(ov[q][hh][0]) + bflo(ov2[q][hh][0]), o1 = bfhi(ov[q][hh][0]) + bfhi(ov2[q][hh][0]);
        const float o2 = bflo(ov[q][hh][1]) + bflo(ov2[q][hh][1]), o3 = bfhi(ov[q][hh][1]) + bfhi(ov2[q][hh][1]);
        ss[q][2 + hh] = o0 * o0 + o1 * o1 + o2 * o2 + o3 * o3;
      }
    }
#pragma unroll
    for (int o = 32; o >= 1; o >>= 1)
#pragma unroll
      for (int q = 0; q < 2; ++q)
#pragma unroll
        for (int k = 0; k < 6; ++k) ss[q][k] += __shfl_xor(ss[q][k], o);
#pragma unroll
    for (int q = 0; q < 2; ++q) {
#pragma unroll
      for (int grp = 0; grp < 2; ++grp) {
        const float rstd = rsqrtf(ss[q][grp] * (1.f / 512.f) + EPS);
        const float4 g0 = sg[grp][0], g1 = sg[grp][1];
        u32x4 o;
        o[0] = pack2(gv[q][grp][0] * rstd * g0.x, gv[q][grp][1] * rstd * g0.y);
        o[1] = pack2(gv[q][grp][2] * rstd * g0.z, gv[q][grp][3] * rstd * g0.w);
        o[2] = pack2(gv[q][grp][4] * rstd * g1.x, gv[q][grp][5] * rstd * g1.y);
        o[3] = pack2(gv[q][grp][6] * rstd * g1.z, gv[q][grp][7] * rstd * g1.w);
        *(u32x4*)(yb + (size_t)(tok + q) * 1536 + grp * 512 + lane * 8) = o;
      }
#pragma unroll
      for (int hh = 0; hh < 4; ++hh) {
        const float rstd = rsqrtf(ss[q][2 + hh] * (1.f / 256.f) + EPS);
        const float o0 = bflo(ov[q][hh][0]) + bflo(ov2[q][hh][0]), o1 = bfhi(ov[q][hh][0]) + bfhi(ov2[q][hh][0]);
        const float o2 = bflo(ov[q][hh][1]) + bflo(ov2[q][hh][1]), o3 = bfhi(ov[q][hh][1]) + bfhi(ov2[q][hh][1]);
        u32x2 o;
        o[0] = pack2(o0 * rstd * gg.x * siluf(bflo(rv[q][hh][0])), o1 * rstd * gg.y * siluf(bfhi(rv[q][hh][0])));
        o[1] = pack2(o2 * rstd * gg.z * siluf(bflo(rv[q][hh][1])), o3 * rstd * gg.w * siluf(bfhi(rv[q][hh][1])));
        *(u32x2*)(ob + (size_t)(tok + q) * 1024 + hh * 256 + lane * 4) = o;
      }
    }
  }
}

__global__ void __launch_bounds__(NT) fwd_megakernel(Params p) {
  extern __shared__ __attribute__((aligned(16))) char smem[];
  __shared__ uint4 xb_words;
  cg::grid_group grid = cg::this_grid();
  unsigned char* ws = p.ws;
  unsigned* bar = (unsigned*)(ws + OFF_BAR);
  if (threadIdx.x == 0) xb_words = make_uint4(0u, 0u, 0u, 0u);
  if (blockIdx.x == 0)
    for (int i = threadIdx.x; i < XCD_BAR_WORDS; i += NT) bar[i] = 0u;
  __syncthreads();
#pragma unroll 1
  for (int step = 0; step < 22; ++step) {
    const int l = step == 0 ? 0 : (step - 1) / 10;
    const int ph = step == 0 ? -1 : (step == 21 ? 10 : (step - 1) % 10);
    const float* mods_l = (const float*)(ws + OFF_MODS) + (size_t)l * 9 * 6144;
    const int r0 = l == 0 ? 0 : TC;
    const int mt0 = l == 0 ? 0 : 8;
    switch (ph) {
      case -1:
        phase_adaln(p, smem);
        break;
      case 0: {
        convert_w(p.in[7] + (size_t)l * 1024 * INC, 1024, INC, (u16*)(ws + OFF_WIN), INP, 1, smem);
        if (l == 0)
          norm_mod<false, false>(p.in[2], p.in[0], nullptr, nullptr, nullptr, nullptr, 0, p.in[6], mods_l, 0, 1024,
                                 (u16*)(ws + OFF_B), 0);
        else
          norm_mod<true, false>((const float*)(ws + OFF_HCTX), p.out, (float*)(ws + OFF_HCTX), p.out,
                                (const u16*)(ws + OFF_A), (const float*)(ws + OFF_MODS) + (size_t)(l - 1) * 9 * 6144, 5120,
                                p.in[6] + l * 1024, mods_l, 0, 1024, (u16*)(ws + OFF_B), 0, (const u16*)(ws + OFF_SLAB));
      } break;
      case 1:
        gemm_stream_phase<EPI_IN>(p, l, (const u16*)(ws + OFF_B), 1024, (const u16*)(ws + OFF_B), 1024, 1 << 30,
                              (const u16*)(ws + OFF_WIN), 1024, 0, 136, 23, smem);
        break;
      case 2:
        phase_conv(p, l);
        break;
      case 3:
        for (int item = blockIdx.x; item < 256; item += gridDim.x) ssd_item(p, l, item, smem);
        break;
      case 4:
        for (int item = blockIdx.x; item < 256; item += gridDim.x) gla_item(p, l, item, smem);
        break;
      case 5:
        convert_w(p.in[17] + (size_t)l * 2048 * 1024, 2048, 1024, (u16*)(ws + OFF_WOUT), 1024, 0, smem);
        phase_gate(p, l, r0);
        break;
      case 6:
        gemm_stream_phase<EPI_DELTA>(p, l, (const u16*)(ws + OFF_B), 1536, (const u16*)(ws + OFF_E), 1024, 16,
                               (const u16*)(ws + OFF_WOUT), 2048, mt0, 136, 4, smem, l == 0 ? NSPLIT : 1,
                               (u16*)(ws + OFF_SLAB));
        break;
      case 7:
        convert_w(p.in[19] + (size_t)l * 1024 * 4096, 1024, 4096, (u16*)(ws + OFF_WFF1), 4096, 0, smem);
        convert_w(p.in[20] + (size_t)l * 4096 * 1024, 4096, 1024, (u16*)(ws + OFF_WFF2), 1024, 0, smem);
        norm_mod<true, false>(l == 0 ? p.in[2] : (const float*)(ws + OFF_HCTX), l == 0 ? p.in[0] : p.out,
                              (float*)(ws + OFF_HCTX), p.out, (const u16*)(ws + OFF_A), mods_l, 2048,
                              p.in[18] + l * 1024, mods_l, 3072, 4096, (u16*)(ws + OFF_B), r0,
                              l == 0 ? (const u16*)(ws + OFF_SLAB) : nullptr);
        break;
      case 8:
        gemm_stream_phase<EPI_FF1>(p, l, (const u16*)(ws + OFF_B), 1024, (const u16*)(ws + OFF_B), 1024, 1 << 30,
                               (const u16*)(ws + OFF_WFF1), 1024, mt0, 136, 16, smem);
        break;
      case 9:
        gemm_stream_phase<EPI_DELTA>(p, l, (const u16*)(ws + OFF_C), 4096, (const u16*)(ws + OFF_C), 4096, 1 << 30,
                               (const u16*)(ws + OFF_WFF2), 4096, mt0, 136, 4, smem, l == 0 ? NSPLIT : 1,
                               (u16*)(ws + OFF_SLAB));
        break;
      default:
        norm_mod<true, true>((const float*)(ws + OFF_HCTX), p.out, (float*)(ws + OFF_HCTX), p.out,
                             (const u16*)(ws + OFF_A), (const float*)(ws + OFF_MODS) + (size_t)9 * 6144, 5120,
                             p.in[21], mods_l, 0, 1024, (u16*)(ws + OFF_B), TC);
        break;
    }
    if (step == 0) {
      grid.sync();
      (void)xcd_barrier_post((unsigned*)(p.ws + OFF_BAR), (volatile LAS unsigned*)&xb_words);
    } else if (step < 21) {
      XcdBarrier xb;
      xb.bar = (unsigned*)(p.ws + OFF_BAR); xb.x = xb_xcc_id(); xb.st = (volatile LAS unsigned*)&xb_words;
      xcd_barrier(xb);
    }
  }
}

extern "C" void kernel_launch(void* const* d_in, const int* in_sizes, int n_in, void* d_out, int out_size,
                              void* d_ws, size_t ws_size, hipStream_t stream) {
  static int grid_blocks = 0;
  if (!grid_blocks) {
    int dev = 0, cus = 0, per_cu = 0;
    (void)hipGetDevice(&dev);
    (void)hipDeviceGetAttribute(&cus, hipDeviceAttributeMultiprocessorCount, dev);
    (void)hipFuncSetAttribute((const void*)fwd_megakernel, hipFuncAttributeMaxDynamicSharedMemorySize, LDS_BYTES);
    (void)hipOccupancyMaxActiveBlocksPerMultiprocessor(&per_cu, fwd_megakernel, NT, LDS_BYTES);
    if (per_cu < 1) per_cu = 1;
    if (per_cu > 1) per_cu = 1;
    if (cus < 1) cus = 256;
    grid_blocks = cus * per_cu;
    if (ws_size < OFF_END) fprintf(stderr, "workspace too small: %zu < %zu\n", ws_size, (size_t)OFF_END);
  }
  Params p{};
  for (int i = 0; i < 22 && i < n_in; ++i) p.in[i] = (const float*)d_in[i];
  p.out = (float*)d_out;
  p.ws = (unsigned char*)d_ws;
  void* args[] = {&p};
  hipError_t e = hipLaunchCooperativeKernel((void*)fwd_megakernel, dim3(grid_blocks), dim3(NT), args, LDS_BYTES, stream);
  if (e != hipSuccess) fprintf(stderr, "cooperative launch failed: %s (grid %d)\n", hipGetErrorString(e), grid_blocks);
}
```
